# Optimizing an MI355X kernel written in HIP

```python
import jax, jax.numpy as jnp
from jax import lax
import numpy as np

D_MODEL = 1024
BATCH = 1
SEQ = 16384
DEPTH = 1
DEC_BATCH = 128
DEC_SEQ = 1
PAST_LEN = 16384
PAGE_SIZE = 128

HEAD_DIM = 64
ATTN_HEADS = 8
KV_HEADS = 2
GQA_GROUP = ATTN_HEADS // KV_HEADS
WINDOW = 128
ROPE_THETA = 10000.0
GM_HEADS = 8
GM_HEAD_DIM = 64
CHUNK = 128
ATTN_WIDTH = ATTN_HEADS * HEAD_DIM
KV_WIDTH = KV_HEADS * HEAD_DIM
GM_WIDTH = GM_HEADS * GM_HEAD_DIM
D_MIX = ATTN_WIDTH + GM_WIDTH
D_IN = ATTN_WIDTH + 2 * KV_WIDTH + 2 * GM_WIDTH
SPLITS = (ATTN_WIDTH, ATTN_WIDTH + KV_WIDTH, ATTN_WIDTH + 2 * KV_WIDTH, ATTN_WIDTH + 2 * KV_WIDTH + GM_WIDTH)
PEER_HEADS = 8
N_KEYS = 128
N_EXPERTS = N_KEYS * N_KEYS
D_KEY = 256
HALF_KEY = D_KEY // 2
TOPK = 16
PEER_BLOCK = 128
EPS = 1e-6
NEG_INF = -1e30

kernel_name = "hymba_swa_sink_gmlp_peer_step"


def rms_norm(x, w):
    xf = x.astype(jnp.float32)
    y = xf * lax.rsqrt(jnp.mean(xf * xf, axis=-1, keepdims=True) + EPS)
    return (y * w.astype(jnp.float32)).astype(x.dtype)


def rope(x, pos):
    half = HEAD_DIM // 2
    inv = ROPE_THETA ** (-jnp.arange(half, dtype=jnp.float32) / half)
    ang = pos.astype(jnp.float32)[:, None] * inv[None, :]
    cos = jnp.cos(ang)[:, None, :]
    sin = jnp.sin(ang)[:, None, :]
    xf = x.astype(jnp.float32)
    x1, x2 = xf[..., :half], xf[..., half:]
    return jnp.concatenate([x1 * cos - x2 * sin, x2 * cos + x1 * sin], axis=-1).astype(x.dtype)


def mixer_inputs(xn, pos, w_in, q_norm_w, k_norm_w, gm_v_norm_w):
    B, S = xn.shape[:2]
    q, k, v, u, gv = jnp.split(xn @ w_in, SPLITS, axis=-1)
    q = rope(rms_norm(q.reshape(B, S, ATTN_HEADS, HEAD_DIM), q_norm_w), pos)
    k = rope(rms_norm(k.reshape(B, S, KV_HEADS, HEAD_DIM), k_norm_w), pos)
    v = v.reshape(B, S, KV_HEADS, HEAD_DIM)
    u = jax.nn.gelu(u, approximate=False)
    gv = rms_norm(jax.nn.gelu(gv, approximate=False).reshape(B, S, GM_HEADS, GM_HEAD_DIM), gm_v_norm_w)
    return q, k, v, u, gv


def sink_attention(q, k, v, sinks, mask):
    B, N, Q = q.shape[:3]
    qg = q.reshape(B, N, Q, KV_HEADS, GQA_GROUP, HEAD_DIM).astype(jnp.float32)
    s = jnp.einsum('bnqkgd,bnlkd->bnkgql', qg, k.astype(jnp.float32)) * (HEAD_DIM ** -0.5)
    s = jnp.where(mask[None, :, None, None], s, NEG_INF)
    sink = sinks.astype(jnp.float32).reshape(KV_HEADS, GQA_GROUP)[None, None, :, :, None, None]
    m = jnp.maximum(jnp.max(s, axis=-1, keepdims=True), sink)
    p = jnp.exp(s - m)
    denom = jnp.sum(p, axis=-1, keepdims=True) + jnp.exp(sink - m)
    o = jnp.einsum('bnkgql,bnlkd->bnqkgd', p / denom, v.astype(jnp.float32))
    return o.reshape(B, N, Q, ATTN_WIDTH).astype(q.dtype)


def spatial_gate(u, gv_chunks, w_spatial, b_spatial):
    C = gv_chunks.shape[2]
    w = jnp.tril(w_spatial[:, :C, :C])
    mixed = jnp.einsum('hts,bnshd->bnthd', w, gv_chunks) + b_spatial[:, :C].T[:, :, None]
    return u * mixed.reshape(u.shape)


def merge_heads(attn, gm, out_norm_w, w_out):
    a = rms_norm(attn, out_norm_w[:ATTN_WIDTH])
    g = rms_norm(gm, out_norm_w[ATTN_WIDTH:])
    return jnp.concatenate([a, g], axis=-1) @ w_out


def peer_tokens(xn, w_query, sub_keys, expert_u, expert_v):
    n = xn.shape[0]
    q = (xn @ w_query).reshape(n, PEER_HEADS, 2, HALF_KEY).astype(jnp.float32)
    s = jnp.einsum('nhpc,hpkc->nhpk', q, sub_keys.astype(jnp.float32))
    s_top, i_top = lax.top_k(s, TOPK)
    cand = (s_top[:, :, 0, :, None] + s_top[:, :, 1, None, :]).reshape(n, PEER_HEADS, TOPK * TOPK)
    best, idx = lax.top_k(cand, TOPK)
    i1 = jnp.take_along_axis(i_top[:, :, 0], idx // TOPK, axis=-1)
    i2 = jnp.take_along_axis(i_top[:, :, 1], idx % TOPK, axis=-1)
    expert = i1 * N_KEYS + i2
    g = jax.nn.softmax(best, axis=-1)
    act = jax.nn.gelu(jnp.einsum('nhkd,nd->nhk', expert_u[expert], xn).astype(jnp.float32), approximate=False)
    return jnp.einsum('nhk,nhkd->nd', (g * act).astype(xn.dtype), expert_v[expert])


def peer(xn, w_query, sub_keys, expert_u, expert_v):
    shp = xn.shape
    flat = xn.reshape(-1, D_MODEL)
    n = flat.shape[0]
    nb = -(-n // PEER_BLOCK)
    flat = jnp.pad(flat, ((0, nb * PEER_BLOCK - n), (0, 0)))
    out = lax.map(lambda blk: peer_tokens(blk, w_query, sub_keys, expert_u, expert_v),
                  flat.reshape(nb, PEER_BLOCK, D_MODEL))
    return out.reshape(-1, D_MODEL)[:n].reshape(shp)


def setup_inputs(seed: int = 0) -> dict:
    key = jax.random.key(seed)
    ks = jax.random.split(key, 20)
    f32 = jnp.float32
    nrm = lambda k, shape, scale: (scale * jax.random.normal(k, shape)).astype(f32)
    gain = lambda k, shape: (1.0 + 0.01 * jax.random.normal(k, shape)).astype(f32)
    return {
        "x_prompt": nrm(ks[0], (BATCH, SEQ, D_MODEL), 1.0),
        "x_sample": nrm(ks[1], (DEC_BATCH, DEC_SEQ, D_MODEL), 1.0),
        "cache_k": nrm(ks[2], (DEPTH, DEC_BATCH, WINDOW, KV_HEADS, HEAD_DIM), 1.0),
        "cache_v": nrm(ks[3], (DEPTH, DEC_BATCH, WINDOW, KV_HEADS, HEAD_DIM), 1.0),
        "norm_mix_w": gain(ks[4], (DEPTH, D_MODEL)),
        "w_in": nrm(ks[5], (DEPTH, D_MODEL, D_IN), D_MODEL ** -0.5),
        "q_norm_w": gain(ks[6], (DEPTH, HEAD_DIM)),
        "k_norm_w": gain(ks[7], (DEPTH, HEAD_DIM)),
        "sinks": nrm(ks[8], (DEPTH, ATTN_HEADS), 0.5),
        "gm_v_norm_w": gain(ks[9], (DEPTH, GM_HEADS, GM_HEAD_DIM)),
        "w_spatial": nrm(ks[10], (DEPTH, GM_HEADS, CHUNK, CHUNK), CHUNK ** -0.5),
        "b_spatial": (1.0 + 0.1 * jax.random.normal(ks[11], (DEPTH, GM_HEADS, CHUNK))).astype(f32),
        "out_norm_w": gain(ks[12], (DEPTH, D_MIX)),
        "w_out": nrm(ks[13], (DEPTH, D_MIX, D_MODEL), D_MIX ** -0.5),
        "norm_ffn_w": gain(ks[14], (DEPTH, D_MODEL)),
        "w_query": nrm(ks[15], (DEPTH, D_MODEL, PEER_HEADS * D_KEY), D_MODEL ** -0.5),
        "sub_keys": nrm(ks[16], (DEPTH, PEER_HEADS, 2, N_KEYS, HALF_KEY), HALF_KEY ** -0.5),
        "expert_u": nrm(ks[17], (DEPTH, N_EXPERTS, D_MODEL), D_MODEL ** -0.5),
        "expert_v": nrm(ks[18], (DEPTH, N_EXPERTS, D_MODEL), D_MODEL ** -0.5),
    }


def reference(x_prompt, x_sample, cache_k, cache_v, norm_mix_w, w_in, q_norm_w, k_norm_w, sinks,
              gm_v_norm_w, w_spatial, b_spatial, out_norm_w, w_out, norm_ffn_w, w_query, sub_keys,
              expert_u, expert_v):
    pos_p = jnp.arange(SEQ, dtype=jnp.int32)
    pos_s = PAST_LEN + jnp.arange(DEC_SEQ, dtype=jnp.int32)
    nb = SEQ // WINDOW
    qi = jnp.arange(WINDOW)[:, None]
    kj = jnp.arange(2 * WINDOW)[None, :]
    diff = qi + WINDOW - kj
    band = (diff >= 0) & (diff < WINDOW)
    mask_p = band[None] & ((jnp.arange(nb)[:, None, None] > 0) | (kj[None] >= WINDOW))
    si = jnp.arange(DEC_SEQ)[:, None]
    sj = jnp.arange(WINDOW + DEC_SEQ)[None, :]
    sdiff = si + WINDOW - sj
    mask_s = ((sdiff >= 0) & (sdiff < WINDOW))[None]

    h_p, h_s = x_prompt, x_sample
    nk_p, nv_p, nk_s, nv_s, ngv_s = [], [], [], [], []
    for layer in range(DEPTH):
        xn = rms_norm(h_p, norm_mix_w[layer])
        q, k, v, u, gv = mixer_inputs(xn, pos_p, w_in[layer], q_norm_w[layer], k_norm_w[layer], gm_v_norm_w[layer])
        kb = k.reshape(BATCH, nb, WINDOW, KV_HEADS, HEAD_DIM)
        vb = v.reshape(BATCH, nb, WINDOW, KV_HEADS, HEAD_DIM)
        pad_blk = ((0, 0), (1, 0), (0, 0), (0, 0), (0, 0))
        k_band = jnp.concatenate([jnp.pad(kb[:, :-1], pad_blk), kb], axis=2)
        v_band = jnp.concatenate([jnp.pad(vb[:, :-1], pad_blk), vb], axis=2)
        attn = sink_attention(q.reshape(BATCH, nb, WINDOW, ATTN_HEADS, HEAD_DIM), k_band, v_band,
                              sinks[layer], mask_p).reshape(BATCH, SEQ, ATTN_WIDTH)
        gm = spatial_gate(u, gv.reshape(BATCH, SEQ // CHUNK, CHUNK, GM_HEADS, GM_HEAD_DIM),
                          w_spatial[layer], b_spatial[layer])
        h_p = h_p + merge_heads(attn, gm, out_norm_w[layer], w_out[layer])
        h_p = h_p + peer(rms_norm(h_p, norm_ffn_w[layer]), w_query[layer], sub_keys[layer], expert_u[layer], expert_v[layer])
        nk_p.append(k[:, -WINDOW:])
        nv_p.append(v[:, -WINDOW:])
        xn = rms_norm(h_s, norm_mix_w[layer])
        q, k, v, u, gv = mixer_inputs(xn, pos_s, w_in[layer], q_norm_w[layer], k_norm_w[layer], gm_v_norm_w[layer])
        k_all = jnp.concatenate([cache_k[layer].astype(k.dtype), k], axis=1)
        v_all = jnp.concatenate([cache_v[layer].astype(v.dtype), v], axis=1)
        attn = sink_attention(q[:, None], k_all[:, None], v_all[:, None], sinks[layer],
                              mask_s).reshape(DEC_BATCH, DEC_SEQ, ATTN_WIDTH)
        gm = spatial_gate(u, gv[:, None], w_spatial[layer], b_spatial[layer])
        h_s = h_s + merge_heads(attn, gm, out_norm_w[layer], w_out[layer])
        h_s = h_s + peer(rms_norm(h_s, norm_ffn_w[layer]), w_query[layer], sub_keys[layer], expert_u[layer], expert_v[layer])
        nk_s.append(k_all[:, -WINDOW:])
        nv_s.append(v_all[:, -WINDOW:])
        ngv_s.append(gv)
    return (h_p, h_s, jnp.stack(nk_p), jnp.stack(nv_p), jnp.stack(nk_s), jnp.stack(nv_s), jnp.stack(ngv_s))
```

```cpp
#include <hip/hip_runtime.h>
#include <hip/hip_cooperative_groups.h>
#include <cstdio>
#include <cstdint>
namespace pg8 {
#define PG8_LAS __attribute__((address_space(3)))
typedef unsigned short bf16_t;
typedef short bf16x8 __attribute__((ext_vector_type(8)));
typedef float f32x4 __attribute__((ext_vector_type(4)));
typedef unsigned u32x4 __attribute__((ext_vector_type(4)));
constexpr int BM = 256, BK = 64, HALF = 128, HTB = HALF * BK * 2  , STAGE_BYTES = 8 * HTB, NXCD = 8, WGM = 8;

__host__ __device__ __forceinline__ int lds_byte(int r, int c) { const int st = (r >> 4) * 2 + (c >> 5), rr = r & 15, cc = c & 31, ob = rr * 64 + cc * 2; return st * 1024 + (ob ^ (((ob >> 9) & 1) << 5)); }
__host__ __device__ __forceinline__ void stage_rc(int b, int& R, int& C) { const int st = b / 1024, sb = b % 1024, swz = sb ^ (((sb >> 9) & 1) << 5); R = (st >> 1) * 16 + swz / 64; C = (st & 1) * 32 + (swz % 64) / 2; }
__host__ __device__ __forceinline__ int perm32(int rho) { const int n = rho >> 4, i = rho & 15; return 8 * (i >> 2) + 4 * n + (i & 3); }

struct Unit { int pm, pn; };
struct Gemm { const bf16_t* A; const bf16_t* Bt; int M, N, K; };

struct StaticOrder {
    int nM, nN, nwg, G, c;
    __host__ __device__ void init(int M, int N, int G_, int c_) { nM = M / BM; nN = N / BM; nwg = nM * nN; G = G_; c = c_; }
    __host__ __device__ bool next(int i, Unit& u) const {
        const long L = (long)i * G + c; if (L >= nwg) return false;
        int wgid = (int)L; { const int q = nwg / NXCD, r = nwg % NXCD, xcd = wgid % NXCD, off = wgid / NXCD; wgid = (xcd < r ? xcd * (q + 1) : r * (q + 1) + (xcd - r) * q) + off; }
        const int nig = WGM * nN, gid = wgid / nig, fm = gid * WGM, gsz = (nM - fm) < WGM ? (nM - fm) : WGM;
        u.pm = fm + ((wgid % nig) % gsz); u.pn = (wgid % nig) / gsz; return true;
    }
    __device__ __forceinline__ void a_ready(const Unit&) const {}
    __device__ __forceinline__ void done(const Unit&) const {}
};

__device__ __forceinline__ unsigned cvt_pk_bf16(float lo, float hi) { unsigned r; asm volatile("v_cvt_pk_bf16_f32 %0, %1, %2" : "=v"(r) : "v"(lo), "v"(hi)); return r; }
typedef float f32x2 __attribute__((ext_vector_type(2)));
__device__ __forceinline__ f32x2 gelu_pk(f32x2 v) {
    const f32x2 av = __builtin_elementwise_abs(v), d = av * 0.2316418882f + 1.0f;
    f32x2 t; t.x = __builtin_amdgcn_rcpf(d.x); t.y = __builtin_amdgcn_rcpf(d.y);
    f32x2 q = t * 0.5307027145f + (-0.7265760135f); q = q * t + 0.7107068705f; q = q * t + (-0.142248368f); q = q * t + 0.127414796f; q = q * t;
    const f32x2 s = (v * v) * (-0.72134752044f);
    f32x2 e; e.x = __builtin_amdgcn_exp2f(s.x); e.y = __builtin_amdgcn_exp2f(s.y);
    const f32x2 m = v * (q * e), r = v - m;
    f32x2 o; o.x = v.x < 0.f ? m.x : r.x; o.y = v.y < 0.f ? m.y : r.y; return o;
}
template <class Epi, class Sched, bool ALIGN_EPI = false, bool SP2 = false>
__device__ __forceinline__ void gemm_phase(PG8_LAS unsigned char* lds, const Gemm g, const Sched& S, const Epi& E) {
    const int tid = threadIdx.x, wid = __builtin_amdgcn_readfirstlane(tid >> 6), lane = tid & 63, wr = wid >> 2, wc = wid & 3, fr = lane & 15, fq = lane >> 4;
    const int K = g.K, nt = K / BK;
    unsigned voffA[2], voffB[2];
#pragma unroll
    for (int i = 0; i < 2; ++i) { int R, C; stage_rc(tid * 16 + i * 8192, R, C); const int Rb = Epi::PERM ? ((R & ~31) + perm32(R & 31)) : R;
        voffA[i] = (unsigned)(R * K + C) * 2u; voffB[i] = (unsigned)(Rb * K + C) * 2u; }
    const size_t kstep = (size_t)(BK * 2);
    const size_t hstep = (size_t)HALF * K * 2;
    const size_t tstep = 2 * hstep;
    const unsigned ldsw = (unsigned)wid * 1024u;
    const int aoff = lds_byte(wr * 64 + fr, fq * 8), boff = lds_byte(wc * 32 + fr, fq * 8);
#define PG8_SA(b, h) (((b) * 2 + (h)) * HTB)
#define PG8_SB(b, h) ((4 + (b) * 2 + (h)) * HTB)
#define PG8_STAGE(bufoff, gbase, voff) do { _Pragma("unroll") for (int _i = 0; _i < 2; ++_i) \
        __builtin_amdgcn_global_load_lds((const unsigned*)((const char*)(gbase) + (voff)[_i]), (PG8_LAS unsigned*)(lds + (bufoff) + ldsw + _i * 8192), 16, 0, 0); } while (0)
#define PG8_LDA(dst, b, h) do { _Pragma("unroll") for (int m = 0; m < 4; ++m) _Pragma("unroll") for (int k = 0; k < 2; ++k) dst[m][k] = *(const PG8_LAS bf16x8*)(lds + PG8_SA(b, h) + aoff + m * 2048 + k * 1024); } while (0)
#define PG8_LDB(dst, b, h) do { _Pragma("unroll") for (int n = 0; n < 2; ++n) _Pragma("unroll") for (int k = 0; k < 2; ++k) dst[n][k] = *(const PG8_LAS bf16x8*)(lds + PG8_SB(b, h) + boff + n * 2048 + k * 1024); } while (0)
#define PG8_MMA(ai, bj, At, Bt) do { __builtin_amdgcn_s_setprio(1); _Pragma("unroll") for (int m = 0; m < 4; ++m) _Pragma("unroll") for (int n = 0; n < 2; ++n) _Pragma("unroll") for (int k = 0; k < 2; ++k) \
        acc[ai][bj][m][n] = __builtin_amdgcn_mfma_f32_16x16x32_bf16(Bt[n][k], At[m][k], acc[ai][bj][m][n], 0, 0, 0); __builtin_amdgcn_s_setprio(0); } while (0)
#define PG8_WAIT_V(n) asm volatile("s_waitcnt vmcnt(" #n ")" ::: "memory")
#define PG8_WAIT_L(n) asm volatile("s_waitcnt lgkmcnt(" #n ")" ::: "memory")
#define PG8_BAR __builtin_amdgcn_s_barrier()
#define PG8_SCHED __builtin_amdgcn_sched_barrier(0)
    Unit cur, nxt; int ui = 0;
    if (!S.next(0, cur)) return;
    f32x4 acc[2][2][4][2];
#pragma unroll
    for (int a = 0; a < 2; ++a)
#pragma unroll
        for (int b = 0; b < 2; ++b)
#pragma unroll
            for (int m = 0; m < 4; ++m)
#pragma unroll
                for (int n = 0; n < 2; ++n) acc[a][b][m][n] = (f32x4){0.f, 0.f, 0.f, 0.f};
    bf16x8 At[4][2], B0[2][2], B1[2][2];
    const char* cA = (const char*)g.A + (size_t)cur.pm * tstep; const char* cB = (const char*)g.Bt + (size_t)cur.pn * tstep;
    S.a_ready(cur);
    if constexpr (SP2) {
        PG8_STAGE(PG8_SB(0, 0), cB, voffB); PG8_STAGE(PG8_SB(0, 1), cB + hstep, voffB); PG8_STAGE(PG8_SA(0, 0), cA, voffA); PG8_STAGE(PG8_SA(0, 1), cA + hstep, voffA);
        if (wr == 1) PG8_BAR;
        PG8_WAIT_V(2); PG8_BAR;
        PG8_STAGE(PG8_SB(1, 0), cB + kstep, voffB); PG8_STAGE(PG8_SA(1, 0), cA + kstep, voffA); PG8_STAGE(PG8_SB(1, 1), cB + hstep + kstep, voffB);
        PG8_WAIT_V(6); PG8_BAR;
    } else {
        PG8_STAGE(PG8_SB(0, 0), cB, voffB); PG8_STAGE(PG8_SA(0, 0), cA, voffA); PG8_STAGE(PG8_SB(0, 1), cB + hstep, voffB); PG8_STAGE(PG8_SA(0, 1), cA + hstep, voffA);
        if (wr == 1) PG8_BAR;
        PG8_WAIT_V(4); PG8_BAR;
        PG8_STAGE(PG8_SB(1, 0), cB + kstep, voffB); PG8_STAGE(PG8_SA(1, 0), cA + kstep, voffA); PG8_STAGE(PG8_SB(1, 1), cB + hstep + kstep, voffB);
        PG8_WAIT_V(6); PG8_BAR;
    }
    for (;;) {
        const bool has_next = S.next(ui + 1, nxt);
        const char* nA = has_next ? (const char*)g.A + (size_t)nxt.pm * tstep : cA; const char* nB = has_next ? (const char*)g.Bt + (size_t)nxt.pn * tstep : cB;
        for (int t = 0; t < nt; t += 2) {
            const bool last = (t == nt - 2);
            const char* a1 = cA + (size_t)(t + 1) * kstep;
            const char* a2 = last ? nA : cA + (size_t)(t + 2) * kstep; const char* b2 = last ? nB : cB + (size_t)(t + 2) * kstep;
            const char* a3 = a2 + kstep; const char* b3 = b2 + kstep;
            if (last && has_next) S.a_ready(nxt);
            if constexpr (SP2) {
            PG8_LDB(B0, 0, 0); PG8_LDB(B1, 0, 1); PG8_SCHED; PG8_LDA(At, 0, 0); PG8_STAGE(PG8_SA(1, 1), a1 + hstep, voffA);
            PG8_WAIT_V(8); PG8_WAIT_L(0); PG8_BAR; PG8_MMA(0, 0, At, B0); PG8_MMA(0, 1, At, B1); PG8_BAR; PG8_SCHED;
            PG8_LDA(At, 0, 1); PG8_STAGE(PG8_SB(0, 0), b2, voffB); PG8_STAGE(PG8_SB(0, 1), b2 + hstep, voffB); PG8_STAGE(PG8_SA(0, 0), a2, voffA);
            PG8_WAIT_V(8); PG8_WAIT_L(0); PG8_BAR; PG8_MMA(1, 0, At, B0); PG8_MMA(1, 1, At, B1); PG8_BAR; PG8_SCHED;
            PG8_LDB(B0, 1, 0); PG8_LDB(B1, 1, 1); PG8_SCHED; PG8_LDA(At, 1, 0); PG8_STAGE(PG8_SA(0, 1), a2 + hstep, voffA);
            PG8_WAIT_V(8); PG8_WAIT_L(0); PG8_BAR; PG8_MMA(0, 0, At, B0); PG8_MMA(0, 1, At, B1); PG8_BAR; PG8_SCHED;
            PG8_LDA(At, 1, 1); PG8_STAGE(PG8_SB(1, 0), b3, voffB); PG8_STAGE(PG8_SB(1, 1), b3 + hstep, voffB); PG8_STAGE(PG8_SA(1, 0), a3, voffA);
            PG8_WAIT_V(8); PG8_WAIT_L(0); PG8_BAR; PG8_MMA(1, 0, At, B0); PG8_MMA(1, 1, At, B1); PG8_BAR; PG8_SCHED;
            } else {
            PG8_LDB(B0, 0, 0); PG8_SCHED; PG8_LDA(At, 0, 0); PG8_STAGE(PG8_SA(1, 1), a1 + hstep, voffA);
            PG8_WAIT_L(8); PG8_BAR; PG8_WAIT_L(0); PG8_MMA(0, 0, At, B0); PG8_BAR; PG8_SCHED;
            PG8_LDB(B1, 0, 1); PG8_STAGE(PG8_SB(0, 0), b2, voffB);
            PG8_BAR; PG8_WAIT_L(0); PG8_MMA(0, 1, At, B1); PG8_BAR;
            PG8_LDA(At, 0, 1); PG8_STAGE(PG8_SA(0, 0), a2, voffA);
            PG8_BAR; PG8_WAIT_L(0); PG8_MMA(1, 0, At, B0); PG8_BAR; PG8_SCHED;
            PG8_STAGE(PG8_SB(0, 1), b2 + hstep, voffB);
            PG8_WAIT_V(6); PG8_BAR; PG8_MMA(1, 1, At, B1); PG8_BAR;
            PG8_LDB(B0, 1, 0); PG8_SCHED; PG8_LDA(At, 1, 0); PG8_STAGE(PG8_SA(0, 1), a2 + hstep, voffA);
            PG8_WAIT_L(8); PG8_BAR; PG8_WAIT_L(0); PG8_MMA(0, 0, At, B0); PG8_BAR; PG8_SCHED;
            PG8_LDB(B1, 1, 1); PG8_STAGE(PG8_SB(1, 0), b3, voffB);
            PG8_BAR; PG8_WAIT_L(0); PG8_MMA(0, 1, At, B1); PG8_BAR;
            PG8_LDA(At, 1, 1); PG8_STAGE(PG8_SA(1, 0), a3, voffA);
            PG8_BAR; PG8_WAIT_L(0); PG8_MMA(1, 0, At, B0); PG8_BAR; PG8_SCHED;
            PG8_STAGE(PG8_SB(1, 1), b3 + hstep, voffB);
            PG8_WAIT_V(6); PG8_BAR; PG8_MMA(1, 1, At, B1); PG8_BAR;
            }
        }
        if constexpr (ALIGN_EPI) { if (wr == 0) PG8_BAR; }
        if constexpr (!Epi::AFTER_DRAIN) { E(acc, cur, wr, wc, fr, fq); S.done(cur); }
        if (!has_next) break;
#pragma unroll
        for (int a = 0; a < 2; ++a)
#pragma unroll
            for (int b = 0; b < 2; ++b)
#pragma unroll
                for (int m = 0; m < 4; ++m)
#pragma unroll
                    for (int n = 0; n < 2; ++n) acc[a][b][m][n] = (f32x4){0.f, 0.f, 0.f, 0.f};
        cur = nxt; cA = nA; cB = nB; ++ui;
        if constexpr (ALIGN_EPI) { if (wr == 1) PG8_BAR; }
    }
    PG8_WAIT_V(0);
    if constexpr (!ALIGN_EPI) { if (wr == 0) PG8_BAR; }
    PG8_BAR;
    if constexpr (Epi::AFTER_DRAIN) { E.fused(acc, cur, wr, wc, fr, fq, lds, wid, lane); S.done(cur); }
#undef PG8_SA
#undef PG8_SB
#undef PG8_STAGE
#undef PG8_LDA
#undef PG8_LDB
#undef PG8_MMA
#undef PG8_WAIT_V
#undef PG8_WAIT_L
#undef PG8_BAR
#undef PG8_SCHED
}
}

constexpr int DM = 1024, SEQ = 16384, NSMP = 128, MTOK = SEQ + NSMP  , MP = 16640  ;
constexpr int DIN = 1792, NQ = 2048, NEXP = 16384;
constexpr float EPS = 1e-6f;
constexpr int NWAVES = 8;

#define GAS __attribute__((address_space(1)))
#define LAS __attribute__((address_space(3)))
typedef unsigned short bf16;
typedef unsigned u32x4 __attribute__((ext_vector_type(4)));
typedef unsigned u32x2 __attribute__((ext_vector_type(2)));
typedef float f32x4 __attribute__((ext_vector_type(4)));
typedef float f32x2 __attribute__((ext_vector_type(2)));
typedef float f32x16 __attribute__((ext_vector_type(16)));
typedef short bf16x8 __attribute__((ext_vector_type(8)));
typedef short s16x4 __attribute__((ext_vector_type(4)));
typedef unsigned short u16x4 __attribute__((ext_vector_type(4)));
typedef int i32x2 __attribute__((ext_vector_type(2)));
typedef __bf16 bf16x2_t __attribute__((ext_vector_type(2)));

constexpr size_t MiB = 1u << 20;
constexpr size_t WS_CTL = 0, CTL_ZERO_BYTES = 1 * MiB;
constexpr size_t WS_WIN = 1 * MiB;
constexpr size_t WS_WO = 5 * MiB;
constexpr size_t WS_WQ = 7 * MiB;
constexpr size_t WS_SK = 11 * MiB;
constexpr size_t WS_WSB = 11 * MiB + 512 * 1024;
constexpr size_t WS_ROWSS = 12 * MiB;
constexpr size_t WS_ROPE = 14 * MiB;
constexpr size_t WS_EU = 20 * MiB;
constexpr size_t WS_EV = 52 * MiB;
constexpr size_t WS_A0 = 84 * MiB;
constexpr size_t WS_A1 = 117 * MiB;
constexpr size_t WS_QB = 150 * MiB;
constexpr size_t WS_KB = 167 * MiB;
constexpr size_t WS_VB = 172 * MiB;
constexpr size_t WS_UB = 177 * MiB;
constexpr size_t WS_GVB = 194 * MiB;
constexpr size_t WS_QP = 150 * MiB;
constexpr size_t WS_ROUTE = 216 * MiB;
constexpr size_t WS_END = 256 * MiB;
static_assert(WS_A0 + (size_t)MP * DM * 2 <= WS_A1 && WS_A1 + (size_t)MP * DM * 2 <= WS_QB && WS_QP + (size_t)MP * NQ * 2 <= WS_ROUTE && WS_ROUTE + (size_t)MTOK * 128 * 8 <= WS_END, "ws map");
static_assert(WS_GVB + (size_t)MP * 512 * 2 <= WS_ROUTE && WS_ROPE + (size_t)16385 * 64 * 4 <= WS_EU && WS_ROWSS + (size_t)16 * MP * 4 <= WS_ROPE, "ws map 2");

constexpr size_t O_Y = 0, O_NKP = 16908288, O_NVP = 16924672, O_NKS = 16941056, O_NVS = 19038208, O_NGV = 21135360, O_END = 21200896;

constexpr int CW_BAR = 4096;

constexpr int SCR_BYTES = 147456;
constexpr int MISC_OFF = SCR_BYTES;
constexpr int LDS_BYTES = SCR_BYTES + 1024;

__device__ __forceinline__ unsigned f2bf(float f) { unsigned u = __builtin_bit_cast(unsigned, f); return (u + 0x7fffu + ((u >> 16) & 1u)) >> 16; }
__device__ __forceinline__ unsigned pk2(float lo, float hi) { f32x2 v = {lo, hi}; bf16x2_t b = __builtin_convertvector(v, bf16x2_t); return __builtin_bit_cast(unsigned, b); }
__device__ __forceinline__ float bf2f(unsigned short b) { return __builtin_bit_cast(float, (unsigned)b << 16); }
__device__ __forceinline__ float bflo(unsigned w) { return __builtin_bit_cast(float, w << 16); }
__device__ __forceinline__ float bfhi(unsigned w) { return __builtin_bit_cast(float, w & 0xffff0000u); }
__device__ __forceinline__ float wave_sum(float v) {
#pragma unroll
    for (int o = 1; o < 64; o <<= 1) v += __shfl_xor(v, o);
    return v;
}
__device__ __forceinline__ float wave_max(float v) {
#pragma unroll
    for (int o = 1; o < 64; o <<= 1) v = fmaxf(v, __shfl_xor(v, o));
    return v;
}
__device__ __forceinline__ int crow(int reg, int h) { return (reg & 3) + 8 * (reg >> 2) + 4 * h; }
__device__ __forceinline__ float gelu1(float v) { f32x2 r = pg8::gelu_pk((f32x2){v, v}); return r.x; }
#define MFMA32(a, b, c) __builtin_amdgcn_mfma_f32_32x32x16_bf16((a), (b), (c), 0, 0, 0)
typedef short v4i16_t __attribute__((ext_vector_type(4)));
__device__ __forceinline__ s16x4 vtr(LAS unsigned char* p) { return __builtin_bit_cast(s16x4, __builtin_amdgcn_ds_read_tr16_b64_v4i16((LAS v4i16_t*)p)); }

#define XB_TMO      128
#define XB_XCNT(j)  (256  + 64 * (j))
#define XB_XSUB(j)  (1280 + 64 * (j))
#define XB_XGEN(j)  (2304 + 64 * (j))
#define XB_TOP      3328
#define XB_TOPGEN   3392
#define XCD_BAR_WORDS 3456
#define XB_SPIN_CAP (1u << 18)

__device__ __forceinline__ unsigned xb_ld(unsigned* p)              { return __hip_atomic_load(p, __ATOMIC_RELAXED, __HIP_MEMORY_SCOPE_AGENT); }
__device__ __forceinline__ unsigned xb_add(unsigned* p, unsigned v) { return __hip_atomic_fetch_add(p, v, __ATOMIC_RELAXED, __HIP_MEMORY_SCOPE_AGENT); }
__device__ __forceinline__ unsigned xb_xcc_id() { return (unsigned)__builtin_amdgcn_s_getreg((3 << 11) | 20) & 0xFu; }
#define XB_SPIN(cond, bar) do { unsigned _sp = 0; while (cond) { __builtin_amdgcn_s_sleep(1); \
    if ((++_sp & 255u) == 0u) { if (xb_ld(&(bar)[XB_TMO])) break; if (_sp > XB_SPIN_CAP) { atomicAdd(&(bar)[XB_TMO], 1u); break; } } } } while (0)

struct XcdBarrier {
    unsigned* bar; unsigned x;
    volatile LAS unsigned* st;
};

__device__ __forceinline__ XcdBarrier xcd_barrier_post(unsigned* bar, volatile LAS unsigned* st) {
    XcdBarrier b; b.bar = bar; b.x = xb_xcc_id(); b.st = st;
    if (threadIdx.x == 0) (void)xb_add(&bar[XB_XCNT(b.x)], 1u);
    return b;
}
__device__ __forceinline__ void xcd_barrier_complete(unsigned* bar, unsigned x, unsigned& nloc, unsigned& nx) {
    const unsigned G = gridDim.x * gridDim.y * gridDim.z;
    unsigned sum, cnt, mine, sp = 0u;
    for (;;) {
        sum = 0u; cnt = 0u; mine = 0u;
#pragma unroll
        for (unsigned j = 0; j < 16; ++j) { const unsigned c = xb_ld(&bar[XB_XCNT(j)]); sum += c; cnt += (c > 0u) ? 1u : 0u; mine = (j == x) ? c : mine; }
        if (sum == G) break;
        __builtin_amdgcn_s_sleep(1);
        if ((++sp & 255u) == 0u) { if (xb_ld(&bar[XB_TMO])) break; if (sp > XB_SPIN_CAP) { atomicAdd(&bar[XB_TMO], 1u); break; } }
    }
    nloc = mine > 0u ? mine : 1u; nx = cnt > 0u ? cnt : 1u;
}

__device__ __forceinline__ void xcd_barrier(const XcdBarrier& b) {
    asm volatile("s_waitcnt vmcnt(0)" ::: "memory");
    __syncthreads();
    if (threadIdx.x == 0) {
        unsigned* bar = b.bar;
        __builtin_amdgcn_s_waitcnt(0);
        unsigned nloc = b.st[0], nx = b.st[1];
        if (nloc == 0u) { xcd_barrier_complete(bar, b.x, nloc, nx); b.st[0] = nloc; b.st[1] = nx; }
        const unsigned old = xb_add(&bar[XB_XSUB(b.x)], 1u);
        const unsigned gen = old / nloc;
        if (old + 1u == (gen + 1u) * nloc) {
            __builtin_amdgcn_fence(__ATOMIC_RELEASE, "agent");
            asm volatile("s_waitcnt vmcnt(0)" ::: "memory");
            const unsigned og = xb_add(&bar[XB_TOP], 1u);
            const unsigned tg = og / nx;
            if (og + 1u == (tg + 1u) * nx) xb_add(&bar[XB_TOPGEN], 1u);
            else XB_SPIN(xb_ld(&bar[XB_TOPGEN]) == tg, bar);
            __builtin_amdgcn_fence(__ATOMIC_ACQUIRE, "agent");
            xb_add(&bar[XB_XGEN(b.x)], 1u);
            asm volatile("s_waitcnt vmcnt(0)" ::: "memory");
        } else {
            XB_SPIN(xb_ld(&bar[XB_XGEN(b.x)]) == gen, bar);
            __builtin_amdgcn_fence(__ATOMIC_ACQUIRE, "agent");
            asm volatile("s_waitcnt vmcnt(0)" ::: "memory");
        }
    }
    __syncthreads();
}

struct Args { const float* in[19]; float* out; unsigned char* ws; int ph_lo, ph_hi, use_bar, pad; };

struct Frame {
    LAS unsigned char* lds;
    int tid, lane, wave, G, bid;
    const float* const* in;
    float* out; unsigned char* ws;
};
__device__ __forceinline__ const float* xrow_ptr(const float* xp, const float* xs, int row) { return row < SEQ ? xp + (size_t)row * DM : xs + (size_t)(row - SEQ) * DM; }

struct EpiIn {
    static constexpr bool PERM = true, AFTER_DRAIN = false;
    bf16 *Qb, *Kb, *Vb, *Ub, *GVb; const float* rope; const float *qnw, *knw, *gnw; float* out;
    __device__ __forceinline__ void operator()(const pg8::f32x4 (&acc)[2][2][4][2], const pg8::Unit& u, int wr, int wc, int fr, int fq) const {
        const int pn = u.pn;
        int kind, head;
        if (pn < 2) { kind = 0; head = pn * 4 + wc; }
        else if (pn == 2) { kind = (wc < 2) ? 1 : 2; head = wc & 1; }
        else if (pn < 5) { kind = 3; head = (pn - 3) * 4 + wc; }
        else { kind = 4; head = (pn - 5) * 4 + wc; }
        float nw[2][8];
        {
            const float* nwp = (kind == 0) ? qnw : (kind == 1) ? knw : (kind == 4) ? gnw + head * 64 : qnw;
#pragma unroll
            for (int bj = 0; bj < 2; ++bj) { const f32x4 a = *(const f32x4*)(nwp + 32 * bj + 8 * fq), b = *(const f32x4*)(nwp + 32 * bj + 8 * fq + 4);
                nw[bj][0] = a[0]; nw[bj][1] = a[1]; nw[bj][2] = a[2]; nw[bj][3] = a[3]; nw[bj][4] = b[0]; nw[bj][5] = b[1]; nw[bj][6] = b[2]; nw[bj][7] = b[3]; }
        }
#pragma unroll
        for (int ai = 0; ai < 2; ++ai)
#pragma unroll
            for (int m = 0; m < 4; ++m) {
                const int row = u.pm * 256 + ai * 128 + wr * 64 + m * 16 + fr;
                const bool ok = row < MTOK;
                float x[2][8];
#pragma unroll
                for (int bj = 0; bj < 2; ++bj)
#pragma unroll
                    for (int n = 0; n < 2; ++n)
#pragma unroll
                        for (int e = 0; e < 4; ++e) x[bj][4 * n + e] = acc[ai][bj][m][n][e];
                if (kind == 3 || kind == 4) {
#pragma unroll
                    for (int bj = 0; bj < 2; ++bj)
#pragma unroll
                        for (int j = 0; j < 8; j += 2) { const f32x2 g = pg8::gelu_pk((f32x2){x[bj][j], x[bj][j + 1]}); x[bj][j] = g.x; x[bj][j + 1] = g.y; }
                }
                if (kind == 0 || kind == 1 || kind == 4) {
                    float ss = 0.f;
#pragma unroll
                    for (int bj = 0; bj < 2; ++bj)
#pragma unroll
                        for (int j = 0; j < 8; ++j) ss += x[bj][j] * x[bj][j];
                    ss += __shfl_xor(ss, 16); ss += __shfl_xor(ss, 32);
                    const float rinv = rsqrtf(ss * (1.0f / 64.0f) + EPS);
#pragma unroll
                    for (int bj = 0; bj < 2; ++bj)
#pragma unroll
                        for (int j = 0; j < 8; ++j) x[bj][j] = x[bj][j] * rinv * nw[bj][j];
                }
                if (kind == 0 || kind == 1) {
                    const int pos = row < SEQ ? row : SEQ;
                    const float* rp = rope + ((size_t)pos * 32 + 8 * fq) * 2;
                    float cs[16];
#pragma unroll
                    for (int t = 0; t < 4; ++t) { const f32x4 v = ok ? *(const f32x4*)(rp + 4 * t) : (f32x4){1.f, 0.f, 1.f, 0.f}; cs[4 * t] = v[0]; cs[4 * t + 1] = v[1]; cs[4 * t + 2] = v[2]; cs[4 * t + 3] = v[3]; }
#pragma unroll
                    for (int j = 0; j < 8; ++j) { const float c = cs[2 * j], s = cs[2 * j + 1], a = x[0][j], b = x[1][j]; x[0][j] = a * c - b * s; x[1][j] = b * c + a * s; }
                }
                if (ok) {
                    bf16* dst; int ld;
                    if (kind == 0) { dst = Qb; ld = 512; } else if (kind == 1) { dst = Kb; ld = 128; } else if (kind == 2) { dst = Vb; ld = 128; } else if (kind == 3) { dst = Ub; ld = 512; } else { dst = GVb; ld = 512; }
                    bf16* rowp = dst + (size_t)row * ld + head * 64 + 8 * fq;
#pragma unroll
                    for (int bj = 0; bj < 2; ++bj) { u32x4 w; w.x = pk2(x[bj][0], x[bj][1]); w.y = pk2(x[bj][2], x[bj][3]); w.z = pk2(x[bj][4], x[bj][5]); w.w = pk2(x[bj][6], x[bj][7]); *(u32x4*)(rowp + 32 * bj) = w; }
                    float* fo = nullptr;
                    if (kind == 1 || kind == 2) {
                        if (row >= SEQ) fo = out + (kind == 1 ? O_NKS : O_NVS) + ((size_t)(row - SEQ) * 128 + 127) * 128 + head * 64;
                        else if (row >= SEQ - 128) fo = out + (kind == 1 ? O_NKP : O_NVP) + (size_t)(row - (SEQ - 128)) * 128 + head * 64;
                    } else if (kind == 4 && row >= SEQ) fo = out + O_NGV + (size_t)(row - SEQ) * 512 + head * 64;
                    if (fo) {
#pragma unroll
                        for (int bj = 0; bj < 2; ++bj) { *(f32x4*)(fo + 32 * bj + 8 * fq) = (f32x4){x[bj][0], x[bj][1], x[bj][2], x[bj][3]}; *(f32x4*)(fo + 32 * bj + 8 * fq + 4) = (f32x4){x[bj][4], x[bj][5], x[bj][6], x[bj][7]}; }
                    }
                }
            }
    }
};

struct EpiOut {
    static constexpr bool PERM = false, AFTER_DRAIN = false;
    const float *xp, *xs; float* out; bf16* HN; float* rowss;
    __device__ __forceinline__ void operator()(const pg8::f32x4 (&acc)[2][2][4][2], const pg8::Unit& u, int wr, int wc, int fr, int fq) const {
#pragma unroll
        for (int ai = 0; ai < 2; ++ai)
#pragma unroll
            for (int m = 0; m < 4; ++m) {
                const int row = u.pm * 256 + ai * 128 + wr * 64 + m * 16 + fr;
                const bool ok = row < MTOK;
                const float* xr = xrow_ptr(xp, xs, ok ? row : 0);
                float ss = 0.f;
#pragma unroll
                for (int bj = 0; bj < 2; ++bj)
#pragma unroll
                    for (int n = 0; n < 2; ++n) {
                        const int col = u.pn * 256 + bj * 128 + wc * 32 + n * 16 + 4 * fq;
                        f32x4 h = acc[ai][bj][m][n];
                        if (ok) { h = h + *(const f32x4*)(xr + col); *(f32x4*)(out + (size_t)row * DM + col) = h;
                            u32x2 w; w.x = pk2(h[0], h[1]); w.y = pk2(h[2], h[3]); *(u32x2*)(HN + (size_t)row * DM + col) = w; }
                        ss += (h[0] * h[0] + h[1] * h[1]) + (h[2] * h[2] + h[3] * h[3]);
                    }
                ss += __shfl_xor(ss, 16); ss += __shfl_xor(ss, 32);
                if (ok && fq == 0) rowss[(size_t)(u.pn * 4 + wc) * MP + row] = ss;
            }
    }
};

struct EpiQ {
    static constexpr bool PERM = true, AFTER_DRAIN = false;
    bf16* QP; const float* rowss;
    __device__ __forceinline__ void operator()(const pg8::f32x4 (&acc)[2][2][4][2], const pg8::Unit& u, int wr, int wc, int fr, int fq) const {
#pragma unroll
        for (int ai = 0; ai < 2; ++ai)
#pragma unroll
            for (int m = 0; m < 4; ++m) {
                const int row = u.pm * 256 + ai * 128 + wr * 64 + m * 16 + fr;
                if (row < MTOK) {
                    float ss = 0.f;
#pragma unroll
                    for (int t = 0; t < 16; ++t) ss += rowss[(size_t)t * MP + row];
                    const float r2 = rsqrtf(ss * (1.0f / 1024.0f) + EPS);
#pragma unroll
                    for (int bj = 0; bj < 2; ++bj) { const f32x4 a = acc[ai][bj][m][0] * r2, b = acc[ai][bj][m][1] * r2;
                        u32x4 w; w.x = pk2(a[0], a[1]); w.y = pk2(a[2], a[3]); w.z = pk2(b[0], b[1]); w.w = pk2(b[2], b[3]);
                        *(u32x4*)(QP + (size_t)row * NQ + u.pn * 256 + bj * 128 + wc * 32 + 8 * fq) = w; }
                }
            }
    }
};

__device__ __forceinline__ void p0_transpose_item(const float* W, const float* fold, int K, int N, bf16* WT, bool perm, LAS float* scr, int item, int lane) {
    const int nblk = N / 32, kb = item / nblk, nb = item % nblk, k0 = 64 * kb, n0 = 32 * nb;
    int l0 = n0;
    if (perm) { const int t = n0 & ~255, loc = n0 & 255, bj = loc >> 7, wc = (loc >> 5) & 3; l0 = t + 64 * wc + 32 * bj; }
#pragma unroll 8
    for (int i = 0; i < 32; ++i) { const int kk = 2 * i + (lane >> 5); scr[kk * 33 + (lane & 31)] = W[(size_t)(k0 + kk) * N + l0 + (lane & 31)] * fold[k0 + kk]; }
    asm volatile("s_waitcnt lgkmcnt(0)" ::: "memory");
    const int c = lane & 7;
#pragma unroll
    for (int j = 0; j < 4; ++j) { const int n = (lane >> 3) + 8 * j; const LAS float* s = scr + (8 * c) * 33 + n;
        u32x4 o; o.x = pk2(s[0 * 33], s[1 * 33]); o.y = pk2(s[2 * 33], s[3 * 33]); o.z = pk2(s[4 * 33], s[5 * 33]); o.w = pk2(s[6 * 33], s[7 * 33]);
        *(u32x4*)(WT + (size_t)(n0 + n) * K + k0 + 8 * c) = o; }
    asm volatile("s_waitcnt lgkmcnt(0)" ::: "memory");
}

__device__ __forceinline__ void p0_prologue(Frame& F) {
    LAS float* scr = (LAS float*)(F.lds + F.wave * 16384);
    const int gw = F.bid * NWAVES + F.wave, NGW = F.G * NWAVES, lane = F.lane;
    const int gt = F.bid * 512 + F.tid, NGT = F.G * 512;
    const float* const* in = F.in;
    unsigned char* ws = F.ws;
    { constexpr int I_IN = 16 * (DIN / 32), I_O = 16 * (DM / 32), I_Q = 16 * (NQ / 32);
      for (int it = gw; it < I_IN + I_O + I_Q; it += NGW) {
          int r = it;
          if (r < I_IN) { p0_transpose_item(in[5], in[4], DM, DIN, (bf16*)(ws + WS_WIN), true, scr, r, lane); continue; } r -= I_IN;
          if (r < I_O) { p0_transpose_item(in[13], in[12], DM, DM, (bf16*)(ws + WS_WO), false, scr, r, lane); continue; } r -= I_O;
          p0_transpose_item(in[15], in[14], DM, NQ, (bf16*)(ws + WS_WQ), false, scr, r, lane);
      } }
    for (int row = gw; row < MP; row += NGW) {
        bf16* o0 = (bf16*)(ws + WS_A0) + (size_t)row * DM;
        if (row < MTOK) {
            const f32x4* xr = (const f32x4*)xrow_ptr(in[0], in[1], row) + lane;
            f32x4 v[4]; float s = 0.f;
#pragma unroll
            for (int j = 0; j < 4; ++j) { v[j] = xr[64 * j]; s += (v[j][0] * v[j][0] + v[j][1] * v[j][1]) + (v[j][2] * v[j][2] + v[j][3] * v[j][3]); }
            const float r1 = rsqrtf(wave_sum(s) * (1.0f / DM) + EPS);
#pragma unroll
            for (int j = 0; j < 4; ++j) { u32x2 w; w.x = pk2(v[j][0] * r1, v[j][1] * r1); w.y = pk2(v[j][2] * r1, v[j][3] * r1); ((u32x2*)o0)[64 * j + lane] = w; }
        } else {
            bf16* o1 = (bf16*)(ws + WS_A1) + (size_t)row * DM;
#pragma unroll
            for (int j = 0; j < 4; ++j) { ((u32x2*)o0)[64 * j + lane] = (u32x2){0u, 0u}; ((u32x2*)o1)[64 * j + lane] = (u32x2){0u, 0u}; }
        }
    }
    for (int row = gw; row < 2 * NEXP; row += NGW) {
        const float* src = (row < NEXP ? in[17] : in[18]) + (size_t)(row & (NEXP - 1)) * DM;
        bf16* dst = (bf16*)(ws + (row < NEXP ? WS_EU : WS_EV)) + (size_t)(row & (NEXP - 1)) * DM;
        f32x4 v[4];
#pragma unroll
        for (int j = 0; j < 4; ++j) v[j] = ((const f32x4*)src)[64 * j + lane];
#pragma unroll
        for (int j = 0; j < 4; ++j) { u32x2 w; w.x = pk2(v[j][0], v[j][1]); w.y = pk2(v[j][2], v[j][3]); ((u32x2*)dst)[64 * j + lane] = w; }
    }
    for (int i = gt; i < 262144 / 4; i += NGT) { const f32x4 v = ((const f32x4*)in[16])[i]; u32x2 w; w.x = pk2(v[0], v[1]); w.y = pk2(v[2], v[3]); ((u32x2*)(ws + WS_SK))[i] = w; }
    for (int i = gt; i < 131072 / 4; i += NGT) { f32x4 v = ((const f32x4*)in[10])[i]; const int e0 = 4 * i, t = (e0 >> 7) & 127, s0 = e0 & 127;
        if (s0 + 0 > t) v[0] = 0.f; if (s0 + 1 > t) v[1] = 0.f; if (s0 + 2 > t) v[2] = 0.f; if (s0 + 3 > t) v[3] = 0.f;
        u32x2 w; w.x = pk2(v[0], v[1]); w.y = pk2(v[2], v[3]); ((u32x2*)(ws + WS_WSB))[i] = w; }
    for (int i = gt; i < 16385 * 32; i += NGT) { const int pos = i >> 5, fi = i & 31;
        const float inv = (float)exp2(-(double)fi * (13.287712379549449 / 32.0));
        const float ang = (float)pos * inv;
        double s, c; sincos((double)ang, &s, &c);
        ((f32x2*)(ws + WS_ROPE))[i] = (f32x2){(float)c, (float)s}; }
    for (int i = gt; i < 2 * NSMP * (127 * 128 / 4); i += NGT) { const int kv = i / (NSMP * 4064), r = i % (NSMP * 4064), b = r / 4064, o = r % 4064;
        const f32x4 v = ((const f32x4*)((kv ? in[3] : in[2]) + (size_t)b * 16384 + 128))[o];
        ((f32x4*)(F.out + (kv ? O_NVS : O_NKS) + (size_t)b * 16384))[o] = v; }
}

constexpr int VS_STRIDE = 272, GS_STRIDE = 1040, RED_OFF = 143360;

__device__ __forceinline__ void store_norm_tile(const f32x16 (&O)[2], float scale, bf16* base  , int h) {
#pragma unroll
    for (int dt = 0; dt < 2; ++dt)
#pragma unroll
        for (int g = 0; g < 4; ++g) { u32x2 w; w.x = pk2(O[dt][4 * g] * scale, O[dt][4 * g + 1] * scale); w.y = pk2(O[dt][4 * g + 2] * scale, O[dt][4 * g + 3] * scale);
            *(u32x2*)(base + 32 * dt + 8 * g + 4 * h) = w; }
}

__device__ __forceinline__ void attn_unit(Frame& F, int tq) {
    const int t0 = 32 * tq, w = F.wave, lane = F.lane, r = lane & 31, h = lane >> 5, kvh = w >> 2;
    const bf16* Qb = (const bf16*)(F.ws + WS_QB); const bf16* Kb = (const bf16*)(F.ws + WS_KB); const bf16* Vb = (const bf16*)(F.ws + WS_VB);
    LAS unsigned char* vs = F.lds; LAS float* red = (LAS float*)(F.lds + RED_OFF);
    for (int ci = F.tid; ci < 160 * 16; ci += 512) { const int ks = ci >> 4, c16 = ci & 15, pos = t0 - 128 + ks;
        u32x4 v = (u32x4){0u, 0u, 0u, 0u}; if (pos >= 0) v = *(const u32x4*)(Vb + (size_t)pos * 128 + c16 * 8);
        *(LAS u32x4*)(vs + ks * VS_STRIDE + c16 * 16) = v; }
    bf16x8 qf[4];
#pragma unroll
    for (int ks = 0; ks < 4; ++ks) qf[ks] = *(const bf16x8*)(Qb + (size_t)(t0 + r) * 512 + w * 64 + 16 * ks + 8 * h);
    f32x16 S[5];
#pragma unroll
    for (int kt = 0; kt < 5; ++kt) {
#pragma unroll
        for (int i = 0; i < 16; ++i) S[kt][i] = 0.f;
        int kp = t0 - 128 + 32 * kt + r; kp = kp < 0 ? 0 : kp;
#pragma unroll
        for (int ks = 0; ks < 4; ++ks) { const bf16x8 kf = *(const bf16x8*)(Kb + (size_t)kp * 128 + kvh * 64 + 16 * ks + 8 * h); S[kt] = MFMA32(kf, qf[ks], S[kt]); }
    }
    const float sink = F.in[8][w];
    float mx = sink;
    const int pq = t0 + r;
#pragma unroll
    for (int kt = 0; kt < 5; ++kt)
#pragma unroll
        for (int i = 0; i < 16; ++i) { const int pk = t0 - 128 + 32 * kt + crow(i, h); const bool valid = (pk >= 0) && (pk <= pq) && (pk >= pq - 127);
            const float s = valid ? S[kt][i] * 0.125f : -1e30f; S[kt][i] = s; mx = fmaxf(mx, s); }
    mx = fmaxf(mx, __shfl_xor(mx, 32));
    float sum = 0.f;
#pragma unroll
    for (int kt = 0; kt < 5; ++kt)
#pragma unroll
        for (int i = 0; i < 16; ++i) { const float p = __expf(S[kt][i] - mx); S[kt][i] = p; sum += p; }
    sum += __shfl_xor(sum, 32); sum += __expf(sink - mx);
    const float inv = 1.0f / sum;
    __syncthreads();
    f32x16 O[2];
#pragma unroll
    for (int i = 0; i < 16; ++i) { O[0][i] = 0.f; O[1][i] = 0.f; }
    const int q = (lane & 15) >> 2, p4 = lane & 3, blk = (lane >> 4) & 1;
#pragma unroll
    for (int kt = 0; kt < 5; ++kt)
#pragma unroll
        for (int s = 0; s < 2; ++s) {
            u32x4 pw; pw.x = pk2(S[kt][8 * s], S[kt][8 * s + 1]); pw.y = pk2(S[kt][8 * s + 2], S[kt][8 * s + 3]); pw.z = pk2(S[kt][8 * s + 4], S[kt][8 * s + 5]); pw.w = pk2(S[kt][8 * s + 6], S[kt][8 * s + 7]);
            const bf16x8 pb = __builtin_bit_cast(bf16x8, pw);
#pragma unroll
            for (int dt = 0; dt < 2; ++dt) {
                LAS unsigned char* a0 = vs + (32 * kt + 16 * s + 4 * h + q) * VS_STRIDE + (kvh * 64 + 32 * dt + 16 * blk + 4 * p4) * 2;
                const s16x4 lo = vtr(a0), hi = vtr(a0 + 8 * VS_STRIDE);
                const bf16x8 va = __builtin_shufflevector(lo, hi, 0, 1, 2, 3, 4, 5, 6, 7);
                O[dt] = MFMA32(va, pb, O[dt]);
            }
        }
    float ss = 0.f;
#pragma unroll
    for (int dt = 0; dt < 2; ++dt)
#pragma unroll
        for (int i = 0; i < 16; ++i) { O[dt][i] *= inv; ss += O[dt][i] * O[dt][i]; }
    ss += __shfl_xor(ss, 32);
    if (h == 0) red[w * 32 + r] = ss;
    __syncthreads();
    float tot = 0.f;
#pragma unroll
    for (int ww = 0; ww < 8; ++ww) tot += red[ww * 32 + r];
    const float rn = rsqrtf(tot * (1.0f / 512.0f) + EPS);
    store_norm_tile(O, rn, (bf16*)(F.ws + WS_A1) + (size_t)(t0 + r) * DM + w * 64, h);
    __syncthreads();
}

__device__ __forceinline__ void gate_unit(Frame& F, int tg) {
    const int chunk = tg >> 2, j = tg & 3, tl0 = 32 * j, g0 = 128 * chunk + tl0, nrows = tl0 + 32;
    const int w = F.wave, lane = F.lane, r = lane & 31, h = lane >> 5;
    const bf16* GVb = (const bf16*)(F.ws + WS_GVB); const bf16* Ub = (const bf16*)(F.ws + WS_UB); const bf16* WsB = (const bf16*)(F.ws + WS_WSB);
    LAS unsigned char* gs = F.lds; LAS float* red = (LAS float*)(F.lds + RED_OFF);
    for (int ci = F.tid; ci < nrows * 64; ci += 512) { const int row = ci >> 6, c16 = ci & 63;
        *(LAS u32x4*)(gs + row * GS_STRIDE + c16 * 16) = *(const u32x4*)(GVb + (size_t)(128 * chunk + row) * 512 + c16 * 8); }
    __syncthreads();
    f32x16 Y[2];
#pragma unroll
    for (int i = 0; i < 16; ++i) { Y[0][i] = 0.f; Y[1][i] = 0.f; }
    const int q = (lane & 15) >> 2, p4 = lane & 3, blk = (lane >> 4) & 1;
    const int nks = nrows >> 4;
    for (int ks = 0; ks < nks; ++ks) {
        const bf16x8 wf = *(const bf16x8*)(WsB + (size_t)(w * 128 + tl0 + r) * 128 + 16 * ks + 8 * h);
#pragma unroll
        for (int dt = 0; dt < 2; ++dt) {
            LAS unsigned char* a0 = gs + (16 * ks + 8 * h + q) * GS_STRIDE + (w * 64 + 32 * dt + 16 * blk + 4 * p4) * 2;
            const s16x4 lo = vtr(a0), hi = vtr(a0 + 4 * GS_STRIDE);
            const bf16x8 ga = __builtin_shufflevector(lo, hi, 0, 1, 2, 3, 4, 5, 6, 7);
            Y[dt] = MFMA32(ga, wf, Y[dt]);
        }
    }
    const float bias = F.in[11][w * 128 + tl0 + r];
    float ss = 0.f;
#pragma unroll
    for (int dt = 0; dt < 2; ++dt)
#pragma unroll
        for (int g = 0; g < 4; ++g) { const u16x4 uu = *(const u16x4*)(Ub + (size_t)(g0 + r) * 512 + w * 64 + 32 * dt + 8 * g + 4 * h);
#pragma unroll
            for (int e = 0; e < 4; ++e) { const float v = bf2f(uu[e]) * (Y[dt][4 * g + e] + bias); Y[dt][4 * g + e] = v; ss += v * v; } }
    ss += __shfl_xor(ss, 32);
    if (h == 0) red[w * 32 + r] = ss;
    __syncthreads();
    float tot = 0.f;
#pragma unroll
    for (int ww = 0; ww < 8; ++ww) tot += red[ww * 32 + r];
    const float rn = rsqrtf(tot * (1.0f / 512.0f) + EPS);
    store_norm_tile(Y, rn, (bf16*)(F.ws + WS_A1) + (size_t)(g0 + r) * DM + 512 + w * 64, h);
    __syncthreads();
}

__device__ __forceinline__ void sample_unit(Frame& F, int b) {
    const int row = SEQ + b, w = F.wave, lane = F.lane, kvh = w >> 2;
    const bf16* Qb = (const bf16*)(F.ws + WS_QB); const bf16* Ub = (const bf16*)(F.ws + WS_UB);
    LAS float* qs = (LAS float*)F.lds + w * 64; LAS float* ps = (LAS float*)(F.lds + 2048) + w * 128; LAS float* red = (LAS float*)(F.lds + RED_OFF);
    qs[lane] = bf2f(Qb[(size_t)row * 512 + w * 64 + lane]);
    __syncthreads();
    const float* ck = F.in[2]; const float* cv = F.in[3];
    float s[2];
#pragma unroll
    for (int i = 0; i < 2; ++i) { const int sj = 1 + lane + 64 * i;
        const float* kp = sj < 128 ? ck + ((size_t)(b * 128 + sj) * 2 + kvh) * 64 : F.out + O_NKS + ((size_t)(b * 128 + 127) * 2 + kvh) * 64;
        float d = 0.f;
#pragma unroll
        for (int c = 0; c < 16; ++c) { const f32x4 kk = ((const f32x4*)kp)[c]; const f32x4 qq = ((LAS f32x4*)qs)[c]; d += (kk[0] * qq[0] + kk[1] * qq[1]) + (kk[2] * qq[2] + kk[3] * qq[3]); }
        s[i] = d * 0.125f; }
    const float sink = F.in[8][w];
    const float mx = fmaxf(wave_max(fmaxf(s[0], s[1])), sink);
    const float p0 = __expf(s[0] - mx), p1 = __expf(s[1] - mx);
    const float sum = wave_sum(p0 + p1) + __expf(sink - mx);
    ps[lane] = p0; ps[64 + lane] = p1;
    __syncthreads();
    float o = 0.f;
    for (int kk = 0; kk < 128; ++kk) { const int sj = kk + 1;
        const float* vp = sj < 128 ? cv + ((size_t)(b * 128 + sj) * 2 + kvh) * 64 : F.out + O_NVS + ((size_t)(b * 128 + 127) * 2 + kvh) * 64;
        o += ps[kk] * vp[lane]; }
    o /= sum;
    const float uu = bf2f(Ub[(size_t)row * 512 + w * 64 + lane]);
    const float gvv = F.out[O_NGV + (size_t)b * 512 + w * 64 + lane];
    const float gm = uu * (F.in[10][(size_t)w * 16384] * gvv + F.in[11][w * 128]);
    const float ssa = wave_sum(o * o), ssg = wave_sum(gm * gm);
    if (lane == 0) { red[w] = ssa; red[8 + w] = ssg; }
    __syncthreads();
    float ta = 0.f, tg2 = 0.f;
#pragma unroll
    for (int ww = 0; ww < 8; ++ww) { ta += red[ww]; tg2 += red[8 + ww]; }
    bf16* mix = (bf16*)(F.ws + WS_A1) + (size_t)row * DM;
    mix[w * 64 + lane] = (bf16)f2bf(o * rsqrtf(ta * (1.0f / 512.0f) + EPS));
    mix[512 + w * 64 + lane] = (bf16)f2bf(gm * rsqrtf(tg2 * (1.0f / 512.0f) + EPS));
    __syncthreads();
}

__device__ __forceinline__ int f2key(float f) { const int b = __builtin_bit_cast(int, f); return b ^ ((b >> 31) & 0x7fffffff); }
__device__ __forceinline__ float key2f(int k) { return __builtin_bit_cast(float, k ^ ((k >> 31) & 0x7fffffff)); }
__device__ __forceinline__ void ce_desc(int& a, int& b) { const int hi = a > b ? a : b, lo = a > b ? b : a; a = hi; b = lo; }
__device__ __forceinline__ void sort16_desc(int (&a)[16]) {
#pragma unroll
    for (int k = 2; k <= 16; k <<= 1)
#pragma unroll
        for (int j = k >> 1; j > 0; j >>= 1)
#pragma unroll
            for (int i = 0; i < 16; ++i) { const int l = i ^ j; if (l > i) { if ((i & k) == 0) ce_desc(a[i], a[l]); else ce_desc(a[l], a[i]); } }
}
__device__ __forceinline__ void merge16_desc(int (&a)[16], const int (&b)[16]) {
#pragma unroll
    for (int i = 0; i < 16; ++i) a[i] = a[i] > b[15 - i] ? a[i] : b[15 - i];
#pragma unroll
    for (int j = 8; j > 0; j >>= 1)
#pragma unroll
        for (int i = 0; i < 16; ++i) { const int l = i ^ j; if (l > i) ce_desc(a[i], a[l]); }
}

__device__ __forceinline__ void route_list(const unsigned char* qbase  , const unsigned char* kbase  , unsigned voffq, unsigned voffk, int (&out)[16]) {
    f32x16 acc[4];
#pragma unroll
    for (int mt = 0; mt < 4; ++mt)
#pragma unroll
        for (int i = 0; i < 16; ++i) acc[mt][i] = 0.f;
#pragma unroll 2
    for (int ks = 0; ks < 8; ++ks) {
        const bf16x8 bq = *(const bf16x8*)(qbase + ks * 32 + voffq);
#pragma unroll
        for (int mt = 0; mt < 4; ++mt) { const bf16x8 ak = *(const bf16x8*)(kbase + mt * 8192 + ks * 32 + voffk); acc[mt] = MFMA32(ak, bq, acc[mt]); }
    }
    int k1[16];
#pragma unroll
    for (int i = 0; i < 16; ++i) { out[i] = (f2key(acc[0][i]) & ~127) | (crow(i, 0)); k1[i] = (f2key(acc[1][i]) & ~127) | (32 + crow(i, 0)); }
    sort16_desc(out); sort16_desc(k1); merge16_desc(out, k1);
    int k2[16];
#pragma unroll
    for (int i = 0; i < 16; ++i) { k2[i] = (f2key(acc[2][i]) & ~127) | (64 + crow(i, 0)); k1[i] = (f2key(acc[3][i]) & ~127) | (96 + crow(i, 0)); }
    sort16_desc(k2); sort16_desc(k1); merge16_desc(k2, k1); merge16_desc(out, k2);
}

__device__ __forceinline__ void route_task(Frame& F, int tg, int hp) {
    const int lane = F.lane, r = lane & 31, h = lane >> 5, w = F.wave;
    const int token = 32 * tg + r;
    const unsigned char* QPu = F.ws + WS_QP + ((size_t)(32 * tg) * NQ + (2 * hp) * 256) * 2;
    const unsigned char* SKu = F.ws + WS_SK + (size_t)((2 * hp) * 2 * 128) * 128 * 2;
    const unsigned voffq = (unsigned)(r * NQ + 8 * h) * 2u, voffk = (unsigned)(r * 128 + 8 * h) * 2u;
    const int h4 = 4 * h;
    int T[2][16];
#pragma unroll
    for (int p = 0; p < 2; ++p) {
        int La[16], Lb[16];
        route_list(QPu + p * 256, SKu + p * 32768, voffq, voffk, La);
        __builtin_amdgcn_sched_barrier(0);
        route_list(QPu + 512 + p * 256, SKu + 65536 + p * 32768, voffq, voffk, Lb);
        __builtin_amdgcn_sched_barrier(0);
        int other[16];
#pragma unroll
        for (int i = 0; i < 16; ++i) { const int send = h ? La[i] : Lb[i]; other[i] = __shfl_xor(send, 32) | (4 - h4); T[p][i] = (h ? Lb[i] : La[i]) | h4; }
        merge16_desc(T[p], other);
        __builtin_amdgcn_sched_barrier(0);
    }
    const int head = 2 * hp + h;
    float v1[16], v2[16];
#pragma unroll
    for (int i = 0; i < 16; ++i) { v1[i] = key2f(T[0][i]); v2[i] = key2f(T[1][i]); }
    int c0[16], c1[16], c2[16], c3[16];
    {
        int n = 0;
#pragma unroll
        for (int i = 0; i < 16; ++i)
#pragma unroll
            for (int j = 0; j < 16; ++j) if ((i + 1) * (j + 1) <= 16) {
                const int key = (f2key(v1[i] + v2[j]) & ~255) | (i * 16 + j);
                if (n < 16) c0[n] = key; else if (n < 32) c1[n - 16] = key; else if (n < 48) c2[n - 32] = key; else c3[n - 48] = key;
                ++n;
            }
#pragma unroll
        for (int t = 2; t < 16; ++t) c3[t] = (int)0x80000000;
    }
    sort16_desc(c0); sort16_desc(c1); sort16_desc(c2); sort16_desc(c3);
    merge16_desc(c0, c1); merge16_desc(c2, c3); merge16_desc(c0, c2);
    LAS unsigned* ib = (LAS unsigned*)(F.lds + w * 2048 + lane * 32);
#pragma unroll
    for (int p = 0; p < 2; ++p)
#pragma unroll
        for (int d = 0; d < 4; ++d) ib[p * 4 + d] = (unsigned)(T[p][4 * d] & 127) | ((unsigned)(T[p][4 * d + 1] & 127) << 8) | ((unsigned)(T[p][4 * d + 2] & 127) << 16) | ((unsigned)(T[p][4 * d + 3] & 127) << 24);
    float best[16]; int ex[16];
    LAS unsigned char* ibb = (LAS unsigned char*)ib;
#pragma unroll
    for (int k = 0; k < 16; ++k) { best[k] = key2f(c0[k]); const int tag = c0[k] & 255; ex[k] = (int)ibb[tag >> 4] * 128 + (int)ibb[16 + (tag & 15)]; }
    float den = 0.f;
#pragma unroll
    for (int k = 0; k < 16; ++k) { best[k] = __expf(best[k] - key2f(c0[0])); den += best[k]; }
    const float rd = 1.0f / den;
    if (token < MTOK) {
        u32x4* dst = (u32x4*)(F.ws + WS_ROUTE + ((size_t)token * 128 + head * 16) * 8);
#pragma unroll
        for (int k = 0; k < 16; k += 2) dst[k >> 1] = (u32x4){(unsigned)ex[k], __builtin_bit_cast(unsigned, best[k] * rd), (unsigned)ex[k + 1], __builtin_bit_cast(unsigned, best[k + 1] * rd)};
    }
}

__device__ __forceinline__ void gather_token(Frame& F, int token) {
    const int lane = F.lane;
    float* hrow = F.out + (size_t)token * DM;
    const bf16* EU = (const bf16*)(F.ws + WS_EU); const bf16* EV = (const bf16*)(F.ws + WS_EV);
    float x[16], hv[16];
    float ss = 0.f;
#pragma unroll
    for (int jj = 0; jj < 2; ++jj) { const f32x4 a = *(const f32x4*)(hrow + 512 * jj + 8 * lane), b = *(const f32x4*)(hrow + 512 * jj + 8 * lane + 4);
#pragma unroll
        for (int e = 0; e < 4; ++e) { hv[8 * jj + e] = a[e]; hv[8 * jj + 4 + e] = b[e]; } }
#pragma unroll
    for (int i = 0; i < 16; ++i) ss += hv[i] * hv[i];
    const float r2 = rsqrtf(wave_sum(ss) * (1.0f / DM) + EPS);
    const float* nfw = F.in[14];
#pragma unroll
    for (int jj = 0; jj < 2; ++jj) { const f32x4 a = *(const f32x4*)(nfw + 512 * jj + 8 * lane), b = *(const f32x4*)(nfw + 512 * jj + 8 * lane + 4);
#pragma unroll
        for (int e = 0; e < 4; ++e) { x[8 * jj + e] = hv[8 * jj + e] * r2 * a[e]; x[8 * jj + 4 + e] = hv[8 * jj + 4 + e] * r2 * b[e]; } }
    const i32x2* rt = (const i32x2*)(F.ws + WS_ROUTE + (size_t)token * 128 * 8);
    const i32x2 e0 = rt[lane], e1 = rt[64 + lane];
    float acc[16];
#pragma unroll
    for (int i = 0; i < 16; ++i) acc[i] = 0.f;
    for (int n0 = 0; n0 < 128; n0 += 8) {
        int eid[8]; float gg[8];
#pragma unroll
        for (int t = 0; t < 8; ++t) { const int n = n0 + t; const i32x2 src = n0 < 64 ? e0 : e1;
            eid[t] = __builtin_amdgcn_readlane(src.x, n & 63); gg[t] = __builtin_bit_cast(float, __builtin_amdgcn_readlane(src.y, n & 63)); }
        u32x4 ur[8][2];
#pragma unroll
        for (int t = 0; t < 8; ++t) { const bf16* up = EU + (size_t)eid[t] * DM + 8 * lane; ur[t][0] = *(const u32x4*)up; ur[t][1] = *(const u32x4*)(up + 512); }
        float wg[8];
#pragma unroll
        for (int t = 0; t < 8; ++t) { float d = 0.f;
#pragma unroll
            for (int jj = 0; jj < 2; ++jj)
#pragma unroll
                for (int c = 0; c < 4; ++c) { const unsigned wv = ur[t][jj][c]; d += bflo(wv) * x[8 * jj + 2 * c] + bfhi(wv) * x[8 * jj + 2 * c + 1]; }
            d = wave_sum(d);
            wg[t] = gg[t] * gelu1(d); }
#pragma unroll
        for (int t = 0; t < 8; ++t) { const bf16* vp = EV + (size_t)eid[t] * DM + 8 * lane; ur[t][0] = *(const u32x4*)vp; ur[t][1] = *(const u32x4*)(vp + 512); }
#pragma unroll
        for (int t = 0; t < 8; ++t)
#pragma unroll
            for (int jj = 0; jj < 2; ++jj)
#pragma unroll
                for (int c = 0; c < 4; ++c) { const unsigned wv = ur[t][jj][c]; acc[8 * jj + 2 * c] += wg[t] * bflo(wv); acc[8 * jj + 2 * c + 1] += wg[t] * bfhi(wv); }
    }
#pragma unroll
    for (int jj = 0; jj < 2; ++jj) {
        *(f32x4*)(hrow + 512 * jj + 8 * lane) = (f32x4){hv[8 * jj] + acc[8 * jj], hv[8 * jj + 1] + acc[8 * jj + 1], hv[8 * jj + 2] + acc[8 * jj + 2], hv[8 * jj + 3] + acc[8 * jj + 3]};
        *(f32x4*)(hrow + 512 * jj + 8 * lane + 4) = (f32x4){hv[8 * jj + 4] + acc[8 * jj + 4], hv[8 * jj + 5] + acc[8 * jj + 5], hv[8 * jj + 6] + acc[8 * jj + 6], hv[8 * jj + 7] + acc[8 * jj + 7]};
    }
}

namespace cg = cooperative_groups;
constexpr int NPHASE = 7;
#ifndef SKIPMASK
#define SKIPMASK 0
#endif
#ifndef MK_BAR_KIND
#define MK_BAR_KIND 1
#endif

__global__ void __launch_bounds__(NWAVES * 64, 2) mk_fwd(Args args) {
    extern __shared__ __attribute__((aligned(16))) unsigned char lds_raw[];
    Frame F;
    F.lds = (LAS unsigned char*)lds_raw;
    F.tid = threadIdx.x; F.lane = F.tid & 63; F.wave = __builtin_amdgcn_readfirstlane(F.tid >> 6);
    F.G = gridDim.x; F.bid = blockIdx.x;
    F.in = args.in; F.out = args.out; F.ws = args.ws;
    volatile LAS unsigned* MISC = (volatile LAS unsigned*)(F.lds + MISC_OFF);
    for (int u = F.tid; u < (LDS_BYTES - MISC_OFF) / 4; u += NWAVES * 64) ((LAS unsigned*)(F.lds + MISC_OFF))[u] = 0u;
    __syncthreads();
    XcdBarrier bar; bar.bar = (unsigned*)(F.ws + WS_CTL) + CW_BAR; bar.x = 0; bar.st = nullptr;
    if (args.use_bar == 2) bar = xcd_barrier_post((unsigned*)(F.ws + WS_CTL) + CW_BAR, MISC + 8);
    const int lo = args.ph_lo, hi = args.ph_hi;
#define IN(k) (lo <= (k) && (k) < hi)
#define SEAM(k) do { if (IN(k) && IN((k) + 1)) { if (args.use_bar == 2) xcd_barrier(bar); else cg::this_grid().sync(); } } while (0)

    if (IN(0) && !(SKIPMASK & 1)) { p0_prologue(F); }
    SEAM(0);
    if (IN(1) && !(SKIPMASK & 2)) {
        pg8::Gemm g{(const pg8::bf16_t*)(F.ws + WS_A0), (const pg8::bf16_t*)(F.ws + WS_WIN), MP, DIN, DM}; pg8::StaticOrder S; S.init(MP, DIN, F.G, F.bid);
        EpiIn E{(bf16*)(F.ws + WS_QB), (bf16*)(F.ws + WS_KB), (bf16*)(F.ws + WS_VB), (bf16*)(F.ws + WS_UB), (bf16*)(F.ws + WS_GVB), (const float*)(F.ws + WS_ROPE), F.in[6], F.in[7], F.in[9], F.out};
        pg8::gemm_phase<EpiIn, pg8::StaticOrder, true, true>(F.lds, g, S, E);
    }
    SEAM(1);
    if (IN(2) && !(SKIPMASK & 4)) {
        constexpr int NU = 512 + 512 + NSMP;
        for (int u = F.bid; u < NU; u += F.G) {
            if (u < 512) gate_unit(F, (u & ~3) | (3 - (u & 3)));
            else if (u < 1024) attn_unit(F, u - 512);
            else sample_unit(F, u - 1024);
        }
    }
    SEAM(2);
    if (IN(3) && !(SKIPMASK & 8)) {
        pg8::Gemm g{(const pg8::bf16_t*)(F.ws + WS_A1), (const pg8::bf16_t*)(F.ws + WS_WO), MP, DM, DM}; pg8::StaticOrder S; S.init(MP, DM, F.G, F.bid);
        EpiOut E{F.in[0], F.in[1], F.out, (bf16*)(F.ws + WS_A0), (float*)(F.ws + WS_ROWSS)};
        pg8::gemm_phase<EpiOut, pg8::StaticOrder, true, true>(F.lds, g, S, E);
    }
    SEAM(3);
    if (IN(4) && !(SKIPMASK & 16)) {
        pg8::Gemm g{(const pg8::bf16_t*)(F.ws + WS_A0), (const pg8::bf16_t*)(F.ws + WS_WQ), MP, NQ, DM}; pg8::StaticOrder S; S.init(MP, NQ, F.G, F.bid);
        EpiQ E{(bf16*)(F.ws + WS_QP), (const float*)(F.ws + WS_ROWSS)};
        pg8::gemm_phase<EpiQ, pg8::StaticOrder, true, true>(F.lds, g, S, E);
    }
    SEAM(4);
    if (IN(5) && !(SKIPMASK & 32)) {
        const int gw = F.bid * NWAVES + F.wave, NGW = F.G * NWAVES;
        for (int t = gw; t < (MP / 32) * 4; t += NGW) route_task(F, t >> 2, t & 3);
    }
    SEAM(5);
    if (IN(6) && !(SKIPMASK & 64)) {
        const int gw = F.bid * NWAVES + F.wave, NGW = F.G * NWAVES;
        for (int t = gw; t < MTOK; t += NGW) gather_token(F, t);
    }
#undef IN
#undef SEAM
}

#ifndef MK_N_LAUNCHES
#define MK_N_LAUNCHES 1
#endif
extern "C" void kernel_launch(void* const* d_in, const int* in_sizes, int n_in, void* d_out, int out_size, void* d_ws, size_t ws_size, hipStream_t stream) {
    static int grid = 0;
    if (grid == 0) {
        if (n_in != 19 || out_size != (int)O_END || ws_size < WS_END) { fprintf(stderr, "kernel_launch: unexpected shapes (n_in %d out %d ws %zu)\n", n_in, out_size, ws_size); grid = -1; return; }
        int dev = 0, cus = 0, per_cu = 0;
        hipGetDevice(&dev); hipDeviceGetAttribute(&cus, hipDeviceAttributeMultiprocessorCount, dev);
        if (hipFuncSetAttribute((const void*)mk_fwd, hipFuncAttributeMaxDynamicSharedMemorySize, LDS_BYTES) != hipSuccess) { fprintf(stderr, "kernel_launch: hipFuncSetAttribute failed\n"); grid = -1; return; }
        if (hipOccupancyMaxActiveBlocksPerMultiprocessor(&per_cu, (const void*)mk_fwd, NWAVES * 64, LDS_BYTES) != hipSuccess || per_cu < 1) { fprintf(stderr, "kernel_launch: occupancy query says %d\n", per_cu); }
        (void)hipGetLastError();
        grid = cus;
    }
    if (grid < 0) return;
    hipMemsetAsync((char*)d_ws + WS_CTL, 0, CTL_ZERO_BYTES, stream);
    Args a{};
    for (int i = 0; i < 19; ++i) a.in[i] = (const float*)d_in[i];
    a.out = (float*)d_out; a.ws = (unsigned char*)d_ws;
#if MK_N_LAUNCHES == 1
    a.ph_lo = 0; a.ph_hi = NPHASE; a.use_bar = MK_BAR_KIND;
    void* kargs[] = {&a};
    hipError_t e = hipLaunchCooperativeKernel((const void*)mk_fwd, dim3(grid), dim3(NWAVES * 64), kargs, LDS_BYTES, stream);
    if (e != hipSuccess) fprintf(stderr, "cooperative launch failed: %s (grid %d)\n", hipGetErrorString(e), grid);
#else
    for (int li = 0; li < NPHASE; ++li) {
        a.ph_lo = li; a.ph_hi = li + 1; a.use_bar = 0;
        hipLaunchKernelGGL(mk_fwd, dim3(grid), dim3(NWAVES * 64), LDS_BYTES, stream, a);
    }
#endif
}
```

```cpp
#include <hip/hip_runtime.h>
#include <hip/hip_cooperative_groups.h>
#include <cstdio>
#include <cstdint>
namespace pg8 {
#define PG8_LAS __attribute__((address_space(3)))
typedef unsigned short bf16_t;
typedef short bf16x8 __attribute__((ext_vector_type(8)));
typedef float f32x4 __attribute__((ext_vector_type(4)));
typedef unsigned u32x4 __attribute__((ext_vector_type(4)));
constexpr int BM = 256, BK = 64, HALF = 128, HTB = HALF * BK * 2  , STAGE_BYTES = 8 * HTB, NXCD = 8, WGM = 8;

__host__ __device__ __forceinline__ int lds_byte(int r, int c) { const int st = (r >> 4) * 2 + (c >> 5), rr = r & 15, cc = c & 31, ob = rr * 64 + cc * 2; return st * 1024 + (ob ^ (((ob >> 9) & 1) << 5)); }
__host__ __device__ __forceinline__ void stage_rc(int b, int& R, int& C) { const int st = b / 1024, sb = b % 1024, swz = sb ^ (((sb >> 9) & 1) << 5); R = (st >> 1) * 16 + swz / 64; C = (st & 1) * 32 + (swz % 64) / 2; }
__host__ __device__ __forceinline__ int perm32(int rho) { const int n = rho >> 4, i = rho & 15; return 8 * (i >> 2) + 4 * n + (i & 3); }

struct Unit { int pm, pn; };
struct Gemm { const bf16_t* A; const bf16_t* Bt; int M, N, K; };

struct StaticOrder {
    int nM, nN, nwg, G, c;
    __host__ __device__ void init(int M, int N, int G_, int c_) { nM = M / BM; nN = N / BM; nwg = nM * nN; G = G_; c = c_; }
    __host__ __device__ bool next(int i, Unit& u) const {
        const long L = (long)i * G + c; if (L >= nwg) return false;
        int wgid = (int)L; { const int q = nwg / NXCD, r = nwg % NXCD, xcd = wgid % NXCD, off = wgid / NXCD; wgid = (xcd < r ? xcd * (q + 1) : r * (q + 1) + (xcd - r) * q) + off; }
        const int nig = WGM * nN, gid = wgid / nig, fm = gid * WGM, gsz = (nM - fm) < WGM ? (nM - fm) : WGM;
        u.pm = fm + ((wgid % nig) % gsz); u.pn = (wgid % nig) / gsz; return true;
    }
    __device__ __forceinline__ void a_ready(const Unit&) const {}
    __device__ __forceinline__ void done(const Unit&) const {}
};

__device__ __forceinline__ unsigned cvt_pk_bf16(float lo, float hi) { unsigned r; asm volatile("v_cvt_pk_bf16_f32 %0, %1, %2" : "=v"(r) : "v"(lo), "v"(hi)); return r; }
typedef float f32x2 __attribute__((ext_vector_type(2)));
__device__ __forceinline__ f32x2 gelu_pk(f32x2 v) {
    const f32x2 av = __builtin_elementwise_abs(v), d = av * 0.2316418882f + 1.0f;
    f32x2 t; t.x = __builtin_amdgcn_rcpf(d.x); t.y = __builtin_amdgcn_rcpf(d.y);
    f32x2 q = t * 0.5307027145f + (-0.7265760135f); q = q * t + 0.7107068705f; q = q * t + (-0.142248368f); q = q * t + 0.127414796f; q = q * t;
    const f32x2 s = (v * v) * (-0.72134752044f);
    f32x2 e; e.x = __builtin_amdgcn_exp2f(s.x); e.y = __builtin_amdgcn_exp2f(s.y);
    const f32x2 m = v * (q * e), r = v - m;
    f32x2 o; o.x = v.x < 0.f ? m.x : r.x; o.y = v.y < 0.f ? m.y : r.y; return o;
}
template <class Epi, class Sched, bool ALIGN_EPI = false, bool SP2 = false>
__device__ __forceinline__ void gemm_phase(PG8_LAS unsigned char* lds, const Gemm g, const Sched& S, const Epi& E) {
    const int tid = threadIdx.x, wid = __builtin_amdgcn_readfirstlane(tid >> 6), lane = tid & 63, wr = wid >> 2, wc = wid & 3, fr = lane & 15, fq = lane >> 4;
    const int K = g.K, nt = K / BK;
    unsigned voffA[2], voffB[2];
#pragma unroll
    for (int i = 0; i < 2; ++i) { int R, C; stage_rc(tid * 16 + i * 8192, R, C); const int Rb = Epi::PERM ? ((R & ~31) + perm32(R & 31)) : R;
        voffA[i] = (unsigned)(R * K + C) * 2u; voffB[i] = (unsigned)(Rb * K + C) * 2u; }
    const size_t kstep = (size_t)(BK * 2);
    const size_t hstep = (size_t)HALF * K * 2;
    const size_t tstep = 2 * hstep;
    const unsigned ldsw = (unsigned)wid * 1024u;
    const int aoff = lds_byte(wr * 64 + fr, fq * 8), boff = lds_byte(wc * 32 + fr, fq * 8);
#define PG8_SA(b, h) (((b) * 2 + (h)) * HTB)
#define PG8_SB(b, h) ((4 + (b) * 2 + (h)) * HTB)
#define PG8_STAGE(bufoff, gbase, voff) do { _Pragma("unroll") for (int _i = 0; _i < 2; ++_i) \
        __builtin_amdgcn_global_load_lds((const unsigned*)((const char*)(gbase) + (voff)[_i]), (PG8_LAS unsigned*)(lds + (bufoff) + ldsw + _i * 8192), 16, 0, 0); } while (0)
#define PG8_LDA(dst, b, h) do { _Pragma("unroll") for (int m = 0; m < 4; ++m) _Pragma("unroll") for (int k = 0; k < 2; ++k) dst[m][k] = *(const PG8_LAS bf16x8*)(lds + PG8_SA(b, h) + aoff + m * 2048 + k * 1024); } while (0)
#define PG8_LDB(dst, b, h) do { _Pragma("unroll") for (int n = 0; n < 2; ++n) _Pragma("unroll") for (int k = 0; k < 2; ++k) dst[n][k] = *(const PG8_LAS bf16x8*)(lds + PG8_SB(b, h) + boff + n * 2048 + k * 1024); } while (0)
#define PG8_MMA(ai, bj, At, Bt) do { __builtin_amdgcn_s_setprio(1); _Pragma("unroll") for (int m = 0; m < 4; ++m) _Pragma("unroll") for (int n = 0; n < 2; ++n) _Pragma("unroll") for (int k = 0; k < 2; ++k) \
        acc[ai][bj][m][n] = __builtin_amdgcn_mfma_f32_16x16x32_bf16(Bt[n][k], At[m][k], acc[ai][bj][m][n], 0, 0, 0); __builtin_amdgcn_s_setprio(0); } while (0)
#define PG8_WAIT_V(n) asm volatile("s_waitcnt vmcnt(" #n ")" ::: "memory")
#define PG8_WAIT_L(n) asm volatile("s_waitcnt lgkmcnt(" #n ")" ::: "memory")
#define PG8_BAR __builtin_amdgcn_s_barrier()
#define PG8_SCHED __builtin_amdgcn_sched_barrier(0)
    Unit cur, nxt; int ui = 0;
    if (!S.next(0, cur)) return;
    f32x4 acc[2][2][4][2];
#pragma unroll
    for (int a = 0; a < 2; ++a)
#pragma unroll
        for (int b = 0; b < 2; ++b)
#pragma unroll
            for (int m = 0; m < 4; ++m)
#pragma unroll
                for (int n = 0; n < 2; ++n) acc[a][b][m][n] = (f32x4){0.f, 0.f, 0.f, 0.f};
    bf16x8 At[4][2], B0[2][2], B1[2][2];
    const char* cA = (const char*)g.A + (size_t)cur.pm * tstep; const char* cB = (const char*)g.Bt + (size_t)cur.pn * tstep;
    S.a_ready(cur);
    if constexpr (SP2) {
        PG8_STAGE(PG8_SB(0, 0), cB, voffB); PG8_STAGE(PG8_SB(0, 1), cB + hstep, voffB); PG8_STAGE(PG8_SA(0, 0), cA, voffA); PG8_STAGE(PG8_SA(0, 1), cA + hstep, voffA);
        if (wr == 1) PG8_BAR;
        PG8_WAIT_V(2); PG8_BAR;
        PG8_STAGE(PG8_SB(1, 0), cB + kstep, voffB); PG8_STAGE(PG8_SA(1, 0), cA + kstep, voffA); PG8_STAGE(PG8_SB(1, 1), cB + hstep + kstep, voffB);
        PG8_WAIT_V(6); PG8_BAR;
    } else {
        PG8_STAGE(PG8_SB(0, 0), cB, voffB); PG8_STAGE(PG8_SA(0, 0), cA, voffA); PG8_STAGE(PG8_SB(0, 1), cB + hstep, voffB); PG8_STAGE(PG8_SA(0, 1), cA + hstep, voffA);
        if (wr == 1) PG8_BAR;
        PG8_WAIT_V(4); PG8_BAR;
        PG8_STAGE(PG8_SB(1, 0), cB + kstep, voffB); PG8_STAGE(PG8_SA(1, 0), cA + kstep, voffA); PG8_STAGE(PG8_SB(1, 1), cB + hstep + kstep, voffB);
        PG8_WAIT_V(6); PG8_BAR;
    }
    for (;;) {
        const bool has_next = S.next(ui + 1, nxt);
        const char* nA = has_next ? (const char*)g.A + (size_t)nxt.pm * tstep : cA; const char* nB = has_next ? (const char*)g.Bt + (size_t)nxt.pn * tstep : cB;
        for (int t = 0; t < nt; t += 2) {
            const bool last = (t == nt - 2);
            const char* a1 = cA + (size_t)(t + 1) * kstep;
            const char* a2 = last ? nA : cA + (size_t)(t + 2) * kstep; const char* b2 = last ? nB : cB + (size_t)(t + 2) * kstep;
            const char* a3 = a2 + kstep; const char* b3 = b2 + kstep;
            if (last && has_next) S.a_ready(nxt);
            if constexpr (SP2) {
            PG8_LDB(B0, 0, 0); PG8_LDB(B1, 0, 1); PG8_SCHED; PG8_LDA(At, 0, 0); PG8_STAGE(PG8_SA(1, 1), a1 + hstep, voffA);
            PG8_WAIT_V(8); PG8_WAIT_L(0); PG8_BAR; PG8_MMA(0, 0, At, B0); PG8_MMA(0, 1, At, B1); PG8_BAR; PG8_SCHED;
            PG8_LDA(At, 0, 1); PG8_STAGE(PG8_SB(0, 0), b2, voffB); PG8_STAGE(PG8_SB(0, 1), b2 + hstep, voffB); PG8_STAGE(PG8_SA(0, 0), a2, voffA);
            PG8_WAIT_V(8); PG8_WAIT_L(0); PG8_BAR; PG8_MMA(1, 0, At, B0); PG8_MMA(1, 1, At, B1); PG8_BAR; PG8_SCHED;
            PG8_LDB(B0, 1, 0); PG8_LDB(B1, 1, 1); PG8_SCHED; PG8_LDA(At, 1, 0); PG8_STAGE(PG8_SA(0, 1), a2 + hstep, voffA);
            PG8_WAIT_V(8); PG8_WAIT_L(0); PG8_BAR; PG8_MMA(0, 0, At, B0); PG8_MMA(0, 1, At, B1); PG8_BAR; PG8_SCHED;
            PG8_LDA(At, 1, 1); PG8_STAGE(PG8_SB(1, 0), b3, voffB); PG8_STAGE(PG8_SB(1, 1), b3 + hstep, voffB); PG8_STAGE(PG8_SA(1, 0), a3, voffA);
            PG8_WAIT_V(8); PG8_WAIT_L(0); PG8_BAR; PG8_MMA(1, 0, At, B0); PG8_MMA(1, 1, At, B1); PG8_BAR; PG8_SCHED;
            } else {
            PG8_LDB(B0, 0, 0); PG8_SCHED; PG8_LDA(At, 0, 0); PG8_STAGE(PG8_SA(1, 1), a1 + hstep, voffA);
            PG8_WAIT_L(8); PG8_BAR; PG8_WAIT_L(0); PG8_MMA(0, 0, At, B0); PG8_BAR; PG8_SCHED;
            PG8_LDB(B1, 0, 1); PG8_STAGE(PG8_SB(0, 0), b2, voffB);
            PG8_BAR; PG8_WAIT_L(0); PG8_MMA(0, 1, At, B1); PG8_BAR;
            PG8_LDA(At, 0, 1); PG8_STAGE(PG8_SA(0, 0), a2, voffA);
            PG8_BAR; PG8_WAIT_L(0); PG8_MMA(1, 0, At, B0); PG8_BAR; PG8_SCHED;
            PG8_STAGE(PG8_SB(0, 1), b2 + hstep, voffB);
            PG8_WAIT_V(6); PG8_BAR; PG8_MMA(1, 1, At, B1); PG8_BAR;
            PG8_LDB(B0, 1, 0); PG8_SCHED; PG8_LDA(At, 1, 0); PG8_STAGE(PG8_SA(0, 1), a2 + hstep, voffA);
            PG8_WAIT_L(8); PG8_BAR; PG8_WAIT_L(0); PG8_MMA(0, 0, At, B0); PG8_BAR; PG8_SCHED;
            PG8_LDB(B1, 1, 1); PG8_STAGE(PG8_SB(1, 0), b3, voffB);
            PG8_BAR; PG8_WAIT_L(0); PG8_MMA(0, 1, At, B1); PG8_BAR;
            PG8_LDA(At, 1, 1); PG8_STAGE(PG8_SA(1, 0), a3, voffA);
            PG8_BAR; PG8_WAIT_L(0); PG8_MMA(1, 0, At, B0); PG8_BAR; PG8_SCHED;
            PG8_STAGE(PG8_SB(1, 1), b3 + hstep, voffB);
            PG8_WAIT_V(6); PG8_BAR; PG8_MMA(1, 1, At, B1); PG8_BAR;
            }
        }
        if constexpr (ALIGN_EPI) { if (wr == 0) PG8_BAR; }
        if constexpr (!Epi::AFTER_DRAIN) { E(acc, cur, wr, wc, fr, fq); S.done(cur); }
        if (!has_next) break;
#pragma unroll
        for (int a = 0; a < 2; ++a)
#pragma unroll
            for (int b = 0; b < 2; ++b)
#pragma unroll
                for (int m = 0; m < 4; ++m)
#pragma unroll
                    for (int n = 0; n < 2; ++n) acc[a][b][m][n] = (f32x4){0.f, 0.f, 0.f, 0.f};
        cur = nxt; cA = nA; cB = nB; ++ui;
        if constexpr (ALIGN_EPI) { if (wr == 1) PG8_BAR; }
    }
    PG8_WAIT_V(0);
    if constexpr (!ALIGN_EPI) { if (wr == 0) PG8_BAR; }
    PG8_BAR;
    if constexpr (Epi::AFTER_DRAIN) { E.fused(acc, cur, wr, wc, fr, fq, lds, wid, lane); S.done(cur); }
#undef PG8_SA
#undef PG8_SB
#undef PG8_STAGE
#undef PG8_LDA
#undef PG8_LDB
#undef PG8_MMA
#undef PG8_WAIT_V
#undef PG8_WAIT_L
#undef PG8_BAR
#undef PG8_SCHED
}
}

constexpr int DM = 1024, SEQ = 16384, NSMP = 128, MTOK = SEQ + NSMP  , MP = 16640  ;
constexpr int DIN = 1792, NQ = 2048, NEXP = 16384;
constexpr float EPS = 1e-6f;
constexpr int NWAVES = 8;

#define GAS __attribute__((address_space(1)))
#define LAS __attribute__((address_space(3)))
typedef unsigned short bf16;
typedef unsigned u32x4 __attribute__((ext_vector_type(4)));
typedef unsigned u32x2 __attribute__((ext_vector_type(2)));
typedef float f32x4 __attribute__((ext_vector_type(4)));
typedef float f32x2 __attribute__((ext_vector_type(2)));
typedef float f32x16 __attribute__((ext_vector_type(16)));
typedef short bf16x8 __attribute__((ext_vector_type(8)));
typedef short s16x4 __attribute__((ext_vector_type(4)));
typedef unsigned short u16x4 __attribute__((ext_vector_type(4)));
typedef int i32x2 __attribute__((ext_vector_type(2)));
typedef __bf16 bf16x2_t __attribute__((ext_vector_type(2)));

constexpr size_t MiB = 1u << 20;
constexpr size_t WS_CTL = 0, CTL_ZERO_BYTES = 1 * MiB;
constexpr size_t WS_WIN = 1 * MiB;
constexpr size_t WS_WO = 5 * MiB;
constexpr size_t WS_WQ = 7 * MiB;
constexpr size_t WS_SK = 11 * MiB;
constexpr size_t WS_WSB = 11 * MiB + 512 * 1024;
constexpr size_t WS_ROWSS = 12 * MiB;
constexpr size_t WS_ROPE = 14 * MiB;
constexpr size_t WS_EU = 20 * MiB;
constexpr size_t WS_EV = 52 * MiB;
constexpr size_t WS_A0 = 84 * MiB;
constexpr size_t WS_A1 = 117 * MiB;
constexpr size_t WS_QB = 150 * MiB;
constexpr size_t WS_KB = 167 * MiB;
constexpr size_t WS_VB = 172 * MiB;
constexpr size_t WS_UB = 177 * MiB;
constexpr size_t WS_GVB = 194 * MiB;
constexpr size_t WS_QP = 150 * MiB;
constexpr size_t WS_ROUTE = 216 * MiB;
constexpr size_t WS_END = 256 * MiB;
static_assert(WS_A0 + (size_t)MP * DM * 2 <= WS_A1 && WS_A1 + (size_t)MP * DM * 2 <= WS_QB && WS_QP + (size_t)MP * NQ * 2 <= WS_ROUTE && WS_ROUTE + (size_t)MTOK * 128 * 8 <= WS_END, "ws map");
static_assert(WS_GVB + (size_t)MP * 512 * 2 <= WS_ROUTE && WS_ROPE + (size_t)16385 * 64 * 4 <= WS_EU && WS_ROWSS + (size_t)16 * MP * 4 <= WS_ROPE, "ws map 2");

constexpr size_t O_Y = 0, O_NKP = 16908288, O_NVP = 16924672, O_NKS = 16941056, O_NVS = 19038208, O_NGV = 21135360, O_END = 21200896;

constexpr int CW_BAR = 4096;

constexpr int SCR_BYTES = 147456;
constexpr int MISC_OFF = SCR_BYTES;
constexpr int LDS_BYTES = SCR_BYTES + 1024;

__device__ __forceinline__ unsigned f2bf(float f) { unsigned u = __builtin_bit_cast(unsigned, f); return (u + 0x7fffu + ((u >> 16) & 1u)) >> 16; }
__device__ __forceinline__ unsigned pk2(float lo, float hi) { f32x2 v = {lo, hi}; bf16x2_t b = __builtin_convertvector(v, bf16x2_t); return __builtin_bit_cast(unsigned, b); }
__device__ __forceinline__ float bf2f(unsigned short b) { return __builtin_bit_cast(float, (unsigned)b << 16); }
__device__ __forceinline__ float bflo(unsigned w) { return __builtin_bit_cast(float, w << 16); }
__device__ __forceinline__ float bfhi(unsigned w) { return __builtin_bit_cast(float, w & 0xffff0000u); }
__device__ __forceinline__ float wave_sum(float v) {
#pragma unroll
    for (int o = 1; o < 64; o <<= 1) v += __shfl_xor(v, o);
    return v;
}
__device__ __forceinline__ float wave_max(float v) {
#pragma unroll
    for (int o = 1; o < 64; o <<= 1) v = fmaxf(v, __shfl_xor(v, o));
    return v;
}
__device__ __forceinline__ int crow(int reg, int h) { return (reg & 3) + 8 * (reg >> 2) + 4 * h; }
__device__ __forceinline__ float gelu1(float v) { f32x2 r = pg8::gelu_pk((f32x2){v, v}); return r.x; }
#define MFMA32(a, b, c) __builtin_amdgcn_mfma_f32_32x32x16_bf16((a), (b), (c), 0, 0, 0)
typedef short v4i16_t __attribute__((ext_vector_type(4)));
__device__ __forceinline__ s16x4 vtr(LAS unsigned char* p) { return __builtin_bit_cast(s16x4, __builtin_amdgcn_ds_read_tr16_b64_v4i16((LAS v4i16_t*)p)); }

#define XB_TMO      128
#define XB_XCNT(j)  (256  + 64 * (j))
#define XB_XSUB(j)  (1280 + 64 * (j))
#define XB_XGEN(j)  (2304 + 64 * (j))
#define XB_TOP      3328
#define XB_TOPGEN   3392
#define XCD_BAR_WORDS 3456
#define XB_SPIN_CAP (1u << 18)

__device__ __forceinline__ unsigned xb_ld(unsigned* p)              { return __hip_atomic_load(p, __ATOMIC_RELAXED, __HIP_MEMORY_SCOPE_AGENT); }
__device__ __forceinline__ unsigned xb_add(unsigned* p, unsigned v) { return __hip_atomic_fetch_add(p, v, __ATOMIC_RELAXED, __HIP_MEMORY_SCOPE_AGENT); }
__device__ __forceinline__ unsigned xb_xcc_id() { return (unsigned)__builtin_amdgcn_s_getreg((3 << 11) | 20) & 0xFu; }
#define XB_SPIN(cond, bar) do { unsigned _sp = 0; while (cond) { __builtin_amdgcn_s_sleep(1); \
    if ((++_sp & 255u) == 0u) { if (xb_ld(&(bar)[XB_TMO])) break; if (_sp > XB_SPIN_CAP) { atomicAdd(&(bar)[XB_TMO], 1u); break; } } } } while (0)

struct XcdBarrier {
    unsigned* bar; unsigned x;
    volatile LAS unsigned* st;
};

__device__ __forceinline__ XcdBarrier xcd_barrier_post(unsigned* bar, volatile LAS unsigned* st) {
    XcdBarrier b; b.bar = bar; b.x = xb_xcc_id(); b.st = st;
    if (threadIdx.x == 0) (void)xb_add(&bar[XB_XCNT(b.x)], 1u);
    return b;
}
__device__ __forceinline__ void xcd_barrier_complete(unsigned* bar, unsigned x, unsigned& nloc, unsigned& nx) {
    const unsigned G = gridDim.x * gridDim.y * gridDim.z;
    unsigned sum, cnt, mine, sp = 0u;
    for (;;) {
        sum = 0u; cnt = 0u; mine = 0u;
#pragma unroll
        for (unsigned j = 0; j < 16; ++j) { const unsigned c = xb_ld(&bar[XB_XCNT(j)]); sum += c; cnt += (c > 0u) ? 1u : 0u; mine = (j == x) ? c : mine; }
        if (sum == G) break;
        __builtin_amdgcn_s_sleep(1);
        if ((++sp & 255u) == 0u) { if (xb_ld(&bar[XB_TMO])) break; if (sp > XB_SPIN_CAP) { atomicAdd(&bar[XB_TMO], 1u); break; } }
    }
    nloc = mine > 0u ? mine : 1u; nx = cnt > 0u ? cnt : 1u;
}

__device__ __forceinline__ void xcd_barrier(const XcdBarrier& b) {
    asm volatile("s_waitcnt vmcnt(0)" ::: "memory");
    __syncthreads();
    if (threadIdx.x == 0) {
        unsigned* bar = b.bar;
        __builtin_amdgcn_s_waitcnt(0);
        unsigned nloc = b.st[0], nx = b.st[1];
        if (nloc == 0u) { xcd_barrier_complete(bar, b.x, nloc, nx); b.st[0] = nloc; b.st[1] = nx; }
        const unsigned old = xb_add(&bar[XB_XSUB(b.x)], 1u);
        const unsigned gen = old / nloc;
        if (old + 1u == (gen + 1u) * nloc) {
            __builtin_amdgcn_fence(__ATOMIC_RELEASE, "agent");
            asm volatile("s_waitcnt vmcnt(0)" ::: "memory");
            const unsigned og = xb_add(&bar[XB_TOP], 1u);
            const unsigned tg = og / nx;
            if (og + 1u == (tg + 1u) * nx) xb_add(&bar[XB_TOPGEN], 1u);
            else XB_SPIN(xb_ld(&bar[XB_TOPGEN]) == tg, bar);
            __builtin_amdgcn_fence(__ATOMIC_ACQUIRE, "agent");
            xb_add(&bar[XB_XGEN(b.x)], 1u);
            asm volatile("s_waitcnt vmcnt(0)" ::: "memory");
        } else {
            XB_SPIN(xb_ld(&bar[XB_XGEN(b.x)]) == gen, bar);
            __builtin_amdgcn_fence(__ATOMIC_ACQUIRE, "agent");
            asm volatile("s_waitcnt vmcnt(0)" ::: "memory");
        }
    }
    __syncthreads();
}

struct Args { const float* in[19]; float* out; unsigned char* ws; int ph_lo, ph_hi, use_bar, pad; };

struct Frame {
    LAS unsigned char* lds;
    int tid, lane, wave, G, bid;
    const float* const* in;
    float* out; unsigned char* ws;
};
__device__ __forceinline__ const float* xrow_ptr(const float* xp, const float* xs, int row) { return row < SEQ ? xp + (size_t)row * DM : xs + (size_t)(row - SEQ) * DM; }

struct EpiIn {
    static constexpr bool PERM = true, AFTER_DRAIN = false;
    bf16 *Qb, *Kb, *Vb, *Ub, *GVb; const float* rope; const float *qnw, *knw, *gnw; float* out;
    __device__ __forceinline__ void operator()(const pg8::f32x4 (&acc)[2][2][4][2], const pg8::Unit& u, int wr, int wc, int fr, int fq) const {
        const int pn = u.pn;
        int kind, head;
        if (pn < 2) { kind = 0; head = pn * 4 + wc; }
        else if (pn == 2) { kind = (wc < 2) ? 1 : 2; head = wc & 1; }
        else if (pn < 5) { kind = 3; head = (pn - 3) * 4 + wc; }
        else { kind = 4; head = (pn - 5) * 4 + wc; }
        float nw[2][8];
        {
            const float* nwp = (kind == 0) ? qnw : (kind == 1) ? knw : (kind == 4) ? gnw + head * 64 : qnw;
#pragma unroll
            for (int bj = 0; bj < 2; ++bj) { const f32x4 a = *(const f32x4*)(nwp + 32 * bj + 8 * fq), b = *(const f32x4*)(nwp + 32 * bj + 8 * fq + 4);
                nw[bj][0] = a[0]; nw[bj][1] = a[1]; nw[bj][2] = a[2]; nw[bj][3] = a[3]; nw[bj][4] = b[0]; nw[bj][5] = b[1]; nw[bj][6] = b[2]; nw[bj][7] = b[3]; }
        }
#pragma unroll
        for (int ai = 0; ai < 2; ++ai)
#pragma unroll
            for (int m = 0; m < 4; ++m) {
                const int row = u.pm * 256 + ai * 128 + wr * 64 + m * 16 + fr;
                const bool ok = row < MTOK;
                float x[2][8];
#pragma unroll
                for (int bj = 0; bj < 2; ++bj)
#pragma unroll
                    for (int n = 0; n < 2; ++n)
#pragma unroll
                        for (int e = 0; e < 4; ++e) x[bj][4 * n + e] = acc[ai][bj][m][n][e];
                if (kind == 3 || kind == 4) {
#pragma unroll
                    for (int bj = 0; bj < 2; ++bj)
#pragma unroll
                        for (int j = 0; j < 8; j += 2) { const f32x2 g = pg8::gelu_pk((f32x2){x[bj][j], x[bj][j + 1]}); x[bj][j] = g.x; x[bj][j + 1] = g.y; }
                }
                if (kind == 0 || kind == 1 || kind == 4) {
                    float ss = 0.f;
#pragma unroll
                    for (int bj = 0; bj < 2; ++bj)
#pragma unroll
                        for (int j = 0; j < 8; ++j) ss += x[bj][j] * x[bj][j];
                    ss += __shfl_xor(ss, 16); ss += __shfl_xor(ss, 32);
                    const float rinv = rsqrtf(ss * (1.0f / 64.0f) + EPS);
#pragma unroll
                    for (int bj = 0; bj < 2; ++bj)
#pragma unroll
                        for (int j = 0; j < 8; ++j) x[bj][j] = x[bj][j] * rinv * nw[bj][j];
                }
                if (kind == 0 || kind == 1) {
                    const int pos = row < SEQ ? row : SEQ;
                    const float* rp = rope + ((size_t)pos * 32 + 8 * fq) * 2;
                    float cs[16];
#pragma unroll
                    for (int t = 0; t < 4; ++t) { const f32x4 v = ok ? *(const f32x4*)(rp + 4 * t) : (f32x4){1.f, 0.f, 1.f, 0.f}; cs[4 * t] = v[0]; cs[4 * t + 1] = v[1]; cs[4 * t + 2] = v[2]; cs[4 * t + 3] = v[3]; }
#pragma unroll
                    for (int j = 0; j < 8; ++j) { const float c = cs[2 * j], s = cs[2 * j + 1], a = x[0][j], b = x[1][j]; x[0][j] = a * c - b * s; x[1][j] = b * c + a * s; }
                }
                if (ok) {
                    bf16* dst; int ld;
                    if (kind == 0) { dst = Qb; ld = 512; } else if (kind == 1) { dst = Kb; ld = 128; } else if (kind == 2) { dst = Vb; ld = 128; } else if (kind == 3) { dst = Ub; ld = 512; } else { dst = GVb; ld = 512; }
                    bf16* rowp = dst + (size_t)row * ld + head * 64 + 8 * fq;
#pragma unroll
                    for (int bj = 0; bj < 2; ++bj) { u32x4 w; w.x = pk2(x[bj][0], x[bj][1]); w.y = pk2(x[bj][2], x[bj][3]); w.z = pk2(x[bj][4], x[bj][5]); w.w = pk2(x[bj][6], x[bj][7]); *(u32x4*)(rowp + 32 * bj) = w; }
                    float* fo = nullptr;
                    if (kind == 1 || kind == 2) {
                        if (row >= SEQ) fo = out + (kind == 1 ? O_NKS : O_NVS) + ((size_t)(row - SEQ) * 128 + 127) * 128 + head * 64;
                        else if (row >= SEQ - 128) fo = out + (kind == 1 ? O_NKP : O_NVP) + (size_t)(row - (SEQ - 128)) * 128 + head * 64;
                    } else if (kind == 4 && row >= SEQ) fo = out + O_NGV + (size_t)(row - SEQ) * 512 + head * 64;
                    if (fo) {
#pragma unroll
                        for (int bj = 0; bj < 2; ++bj) { *(f32x4*)(fo + 32 * bj + 8 * fq) = (f32x4){x[bj][0], x[bj][1], x[bj][2], x[bj][3]}; *(f32x4*)(fo + 32 * bj + 8 * fq + 4) = (f32x4){x[bj][4], x[bj][5], x[bj][6], x[bj][7]}; }
                    }
                }
            }
    }
};

struct EpiOut {
    static constexpr bool PERM = false, AFTER_DRAIN = false;
    const float *xp, *xs; float* out; bf16* HN; float* rowss;
    __device__ __forceinline__ void operator()(const pg8::f32x4 (&acc)[2][2][4][2], const pg8::Unit& u, int wr, int wc, int fr, int fq) const {
#pragma unroll
        for (int ai = 0; ai < 2; ++ai)
#pragma unroll
            for (int m = 0; m < 4; ++m) {
                const int row = u.pm * 256 + ai * 128 + wr * 64 + m * 16 + fr;
                const bool ok = row < MTOK;
                const float* xr = xrow_ptr(xp, xs, ok ? row : 0);
                float ss = 0.f;
#pragma unroll
                for (int bj = 0; bj < 2; ++bj)
#pragma unroll
                    for (int n = 0; n < 2; ++n) {
                        const int col = u.pn * 256 + bj * 128 + wc * 32 + n * 16 + 4 * fq;
                        f32x4 h = acc[ai][bj][m][n];
                        if (ok) { h = h + *(const f32x4*)(xr + col); *(f32x4*)(out + (size_t)row * DM + col) = h;
                            u32x2 w; w.x = pk2(h[0], h[1]); w.y = pk2(h[2], h[3]); *(u32x2*)(HN + (size_t)row * DM + col) = w; }
                        ss += (h[0] * h[0] + h[1] * h[1]) + (h[2] * h[2] + h[3] * h[3]);
                    }
                ss += __shfl_xor(ss, 16); ss += __shfl_xor(ss, 32);
                if (ok && fq == 0) rowss[(size_t)(u.pn * 4 + wc) * MP + row] = ss;
            }
    }
};

struct EpiQ {
    static constexpr bool PERM = true, AFTER_DRAIN = false;
    bf16* QP; const float* rowss;
    __device__ __forceinline__ void operator()(const pg8::f32x4 (&acc)[2][2][4][2], const pg8::Unit& u, int wr, int wc, int fr, int fq) const {
#pragma unroll
        for (int ai = 0; ai < 2; ++ai)
#pragma unroll
            for (int m = 0; m < 4; ++m) {
                const int row = u.pm * 256 + ai * 128 + wr * 64 + m * 16 + fr;
                if (row < MTOK) {
                    float ss = 0.f;
#pragma unroll
                    for (int t = 0; t < 16; ++t) ss += rowss[(size_t)t * MP + row];
                    const float r2 = rsqrtf(ss * (1.0f / 1024.0f) + EPS);
#pragma unroll
                    for (int bj = 0; bj < 2; ++bj) { const f32x4 a = acc[ai][bj][m][0] * r2, b = acc[ai][bj][m][1] * r2;
                        u32x4 w; w.x = pk2(a[0], a[1]); w.y = pk2(a[2], a[3]); w.z = pk2(b[0], b[1]); w.w = pk2(b[2], b[3]);
                        *(u32x4*)(QP + (size_t)row * NQ + u.pn * 256 + bj * 128 + wc * 32 + 8 * fq) = w; }
                }
            }
    }
};

__device__ __forceinline__ void p0_transpose_item(const float* W, const float* fold, int K, int N, bf16* WT, bool perm, LAS float* scr, int item, int lane) {
    const int nblk = N / 32, kb = item / nblk, nb = item % nblk, k0 = 64 * kb, n0 = 32 * nb;
    int l0 = n0;
    if (perm) { const int t = n0 & ~255, loc = n0 & 255, bj = loc >> 7, wc = (loc >> 5) & 3; l0 = t + 64 * wc + 32 * bj; }
#pragma unroll 8
    for (int i = 0; i < 32; ++i) { const int kk = 2 * i + (lane >> 5); scr[kk * 33 + (lane & 31)] = W[(size_t)(k0 + kk) * N + l0 + (lane & 31)] * fold[k0 + kk]; }
    asm volatile("s_waitcnt lgkmcnt(0)" ::: "memory");
    const int c = lane & 7;
#pragma unroll
    for (int j = 0; j < 4; ++j) { const int n = (lane >> 3) + 8 * j; const LAS float* s = scr + (8 * c) * 33 + n;
        u32x4 o; o.x = pk2(s[0 * 33], s[1 * 33]); o.y = pk2(s[2 * 33], s[3 * 33]); o.z = pk2(s[4 * 33], s[5 * 33]); o.w = pk2(s[6 * 33], s[7 * 33]);
        *(u32x4*)(WT + (size_t)(n0 + n) * K + k0 + 8 * c) = o; }
    asm volatile("s_waitcnt lgkmcnt(0)" ::: "memory");
}

__device__ __forceinline__ void p0_prologue(Frame& F) {
    LAS float* scr = (LAS float*)(F.lds + F.wave * 16384);
    const int gw = F.bid * NWAVES + F.wave, NGW = F.G * NWAVES, lane = F.lane;
    const int gt = F.bid * 512 + F.tid, NGT = F.G * 512;
    const float* const* in = F.in;
    unsigned char* ws = F.ws;
    { constexpr int I_IN = 16 * (DIN / 32), I_O = 16 * (DM / 32), I_Q = 16 * (NQ / 32);
      for (int it = gw; it < I_IN + I_O + I_Q; it += NGW) {
          int r = it;
          if (r < I_IN) { p0_transpose_item(in[5], in[4], DM, DIN, (bf16*)(ws + WS_WIN), true, scr, r, lane); continue; } r -= I_IN;
          if (r < I_O) { p0_transpose_item(in[13], in[12], DM, DM, (bf16*)(ws + WS_WO), false, scr, r, lane); continue; } r -= I_O;
          p0_transpose_item(in[15], in[14], DM, NQ, (bf16*)(ws + WS_WQ), false, scr, r, lane);
      } }
    for (int row = gw; row < MP; row += NGW) {
        bf16* o0 = (bf16*)(ws + WS_A0) + (size_t)row * DM;
        if (row < MTOK) {
            const f32x4* xr = (const f32x4*)xrow_ptr(in[0], in[1], row) + lane;
            f32x4 v[4]; float s = 0.f;
#pragma unroll
            for (int j = 0; j < 4; ++j) { v[j] = xr[64 * j]; s += (v[j][0] * v[j][0] + v[j][1] * v[j][1]) + (v[j][2] * v[j][2] + v[j][3] * v[j][3]); }
            const float r1 = rsqrtf(wave_sum(s) * (1.0f / DM) + EPS);
#pragma unroll
            for (int j = 0; j < 4; ++j) { u32x2 w; w.x = pk2(v[j][0] * r1, v[j][1] * r1); w.y = pk2(v[j][2] * r1, v[j][3] * r1); ((u32x2*)o0)[64 * j + lane] = w; }
        } else {
            bf16* o1 = (bf16*)(ws + WS_A1) + (size_t)row * DM;
#pragma unroll
            for (int j = 0; j < 4; ++j) { ((u32x2*)o0)[64 * j + lane] = (u32x2){0u, 0u}; ((u32x2*)o1)[64 * j + lane] = (u32x2){0u, 0u}; }
        }
    }
    for (int row = gw; row < 2 * NEXP; row += NGW) {
        const float* src = (row < NEXP ? in[17] : in[18]) + (size_t)(row & (NEXP - 1)) * DM;
        bf16* dst = (bf16*)(ws + (row < NEXP ? WS_EU : WS_EV)) + (size_t)(row & (NEXP - 1)) * DM;
        f32x4 v[4];
#pragma unroll
        for (int j = 0; j < 4; ++j) v[j] = ((const f32x4*)src)[64 * j + lane];
#pragma unroll
        for (int j = 0; j < 4; ++j) { u32x2 w; w.x = pk2(v[j][0], v[j][1]); w.y = pk2(v[j][2], v[j][3]); ((u32x2*)dst)[64 * j + lane] = w; }
    }
    for (int i = gt; i < 262144 / 4; i += NGT) { const f32x4 v = ((const f32x4*)in[16])[i]; u32x2 w; w.x = pk2(v[0], v[1]); w.y = pk2(v[2], v[3]); ((u32x2*)(ws + WS_SK))[i] = w; }
    for (int i = gt; i < 131072 / 4; i += NGT) { f32x4 v = ((const f32x4*)in[10])[i]; const int e0 = 4 * i, t = (e0 >> 7) & 127, s0 = e0 & 127;
        if (s0 + 0 > t) v[0] = 0.f; if (s0 + 1 > t) v[1] = 0.f; if (s0 + 2 > t) v[2] = 0.f; if (s0 + 3 > t) v[3] = 0.f;
        u32x2 w; w.x = pk2(v[0], v[1]); w.y = pk2(v[2], v[3]); ((u32x2*)(ws + WS_WSB))[i] = w; }
    for (int i = gt; i < 16385 * 32; i += NGT) { const int pos = i >> 5, fi = i & 31;
        const float inv = (float)exp2(-(double)fi * (13.287712379549449 / 32.0));
        const float ang = (float)pos * inv;
        double s, c; sincos((double)ang, &s, &c);
        ((f32x2*)(ws + WS_ROPE))[i] = (f32x2){(float)c, (float)s}; }
    for (int i = gt; i < 2 * NSMP * (127 * 128 / 4); i += NGT) { const int kv = i / (NSMP * 4064), r = i % (NSMP * 4064), b = r / 4064, o = r % 4064;
        const f32x4 v = ((const f32x4*)((kv ? in[3] : in[2]) + (size_t)b * 16384 + 128))[o];
        ((f32x4*)(F.out + (kv ? O_NVS : O_NKS) + (size_t)b * 16384))[o] = v; }
}

constexpr int VS_STRIDE = 272, GS_STRIDE = 1040, RED_OFF = 143360;

__device__ __forceinline__ void store_norm_tile(const f32x16 (&O)[2], float scale, bf16* base  , int h) {
#pragma unroll
    for (int dt = 0; dt < 2; ++dt)
#pragma unroll
        for (int g = 0; g < 4; ++g) { u32x2 w; w.x = pk2(O[dt][4 * g] * scale, O[dt][4 * g + 1] * scale); w.y = pk2(O[dt][4 * g + 2] * scale, O[dt][4 * g + 3] * scale);
            *(u32x2*)(base + 32 * dt + 8 * g + 4 * h) = w; }
}

__device__ __forceinline__ void attn_unit(Frame& F, int tq) {
    const int t0 = 32 * tq, w = F.wave, lane = F.lane, r = lane & 31, h = lane >> 5, kvh = w >> 2;
    const bf16* Qb = (const bf16*)(F.ws + WS_QB); const bf16* Kb = (const bf16*)(F.ws + WS_KB); const bf16* Vb = (const bf16*)(F.ws + WS_VB);
    LAS unsigned char* vs = F.lds; LAS float* red = (LAS float*)(F.lds + RED_OFF);
    for (int ci = F.tid; ci < 160 * 16; ci += 512) { const int ks = ci >> 4, c16 = ci & 15, pos = t0 - 128 + ks;
        u32x4 v = (u32x4){0u, 0u, 0u, 0u}; if (pos >= 0) v = *(const u32x4*)(Vb + (size_t)pos * 128 + c16 * 8);
        *(LAS u32x4*)(vs + ks * VS_STRIDE + c16 * 16) = v; }
    bf16x8 qf[4];
#pragma unroll
    for (int ks = 0; ks < 4; ++ks) qf[ks] = *(const bf16x8*)(Qb + (size_t)(t0 + r) * 512 + w * 64 + 16 * ks + 8 * h);
    f32x16 S[5];
#pragma unroll
    for (int kt = 0; kt < 5; ++kt) {
#pragma unroll
        for (int i = 0; i < 16; ++i) S[kt][i] = 0.f;
        int kp = t0 - 128 + 32 * kt + r; kp = kp < 0 ? 0 : kp;
#pragma unroll
        for (int ks = 0; ks < 4; ++ks) { const bf16x8 kf = *(const bf16x8*)(Kb + (size_t)kp * 128 + kvh * 64 + 16 * ks + 8 * h); S[kt] = MFMA32(kf, qf[ks], S[kt]); }
    }
    const float sink = F.in[8][w];
    float mx = sink;
    const int pq = t0 + r;
#pragma unroll
    for (int kt = 0; kt < 5; ++kt)
#pragma unroll
        for (int i = 0; i < 16; ++i) { const int pk = t0 - 128 + 32 * kt + crow(i, h); const bool valid = (pk >= 0) && (pk <= pq) && (pk >= pq - 127);
            const float s = valid ? S[kt][i] * 0.125f : -1e30f; S[kt][i] = s; mx = fmaxf(mx, s); }
    mx = fmaxf(mx, __shfl_xor(mx, 32));
    float sum = 0.f;
#pragma unroll
    for (int kt = 0; kt < 5; ++kt)
#pragma unroll
        for (int i = 0; i < 16; ++i) { const float p = __expf(S[kt][i] - mx); S[kt][i] = p; sum += p; }
    sum += __shfl_xor(sum, 32); sum += __expf(sink - mx);
    const float inv = 1.0f / sum;
    __syncthreads();
    f32x16 O[2];
#pragma unroll
    for (int i = 0; i < 16; ++i) { O[0][i] = 0.f; O[1][i] = 0.f; }
    const int q = (lane & 15) >> 2, p4 = lane & 3, blk = (lane >> 4) & 1;
#pragma unroll
    for (int kt = 0; kt < 5; ++kt)
#pragma unroll
        for (int s = 0; s < 2; ++s) {
            u32x4 pw; pw.x = pk2(S[kt][8 * s], S[kt][8 * s + 1]); pw.y = pk2(S[kt][8 * s + 2], S[kt][8 * s + 3]); pw.z = pk2(S[kt][8 * s + 4], S[kt][8 * s + 5]); pw.w = pk2(S[kt][8 * s + 6], S[kt][8 * s + 7]);
            const bf16x8 pb = __builtin_bit_cast(bf16x8, pw);
#pragma unroll
            for (int dt = 0; dt < 2; ++dt) {
                LAS unsigned char* a0 = vs + (32 * kt + 16 * s + 4 * h + q) * VS_STRIDE + (kvh * 64 + 32 * dt + 16 * blk + 4 * p4) * 2;
                const s16x4 lo = vtr(a0), hi = vtr(a0 + 8 * VS_STRIDE);
                const bf16x8 va = __builtin_shufflevector(lo, hi, 0, 1, 2, 3, 4, 5, 6, 7);
                O[dt] = MFMA32(va, pb, O[dt]);
            }
        }
    float ss = 0.f;
#pragma unroll
    for (int dt = 0; dt < 2; ++dt)
#pragma unroll
        for (int i = 0; i < 16; ++i) { O[dt][i] *= inv; ss += O[dt][i] * O[dt][i]; }
    ss += __shfl_xor(ss, 32);
    if (h == 0) red[w * 32 + r] = ss;
    __syncthreads();
    float tot = 0.f;
#pragma unroll
    for (int ww = 0; ww < 8; ++ww) tot += red[ww * 32 + r];
    const float rn = rsqrtf(tot * (1.0f / 512.0f) + EPS);
    store_norm_tile(O, rn, (bf16*)(F.ws + WS_A1) + (size_t)(t0 + r) * DM + w * 64, h);
    __syncthreads();
}

__device__ __forceinline__ void gate_unit(Frame& F, int tg) {
    const int chunk = tg >> 2, j = tg & 3, tl0 = 32 * j, g0 = 128 * chunk + tl0, nrows = tl0 + 32;
    const int w = F.wave, lane = F.lane, r = lane & 31, h = lane >> 5;
    const bf16* GVb = (const bf16*)(F.ws + WS_GVB); const bf16* Ub = (const bf16*)(F.ws + WS_UB); const bf16* WsB = (const bf16*)(F.ws + WS_WSB);
    LAS unsigned char* gs = F.lds; LAS float* red = (LAS float*)(F.lds + RED_OFF);
    for (int ci = F.tid; ci < nrows * 64; ci += 512) { const int row = ci >> 6, c16 = ci & 63;
        *(LAS u32x4*)(gs + row * GS_STRIDE + c16 * 16) = *(const u32x4*)(GVb + (size_t)(128 * chunk + row) * 512 + c16 * 8); }
    __syncthreads();
    f32x16 Y[2];
#pragma unroll
    for (int i = 0; i < 16; ++i) { Y[0][i] = 0.f; Y[1][i] = 0.f; }
    const int q = (lane & 15) >> 2, p4 = lane & 3, blk = (lane >> 4) & 1;
    const int nks = nrows >> 4;
    for (int ks = 0; ks < nks; ++ks) {
        const bf16x8 wf = *(const bf16x8*)(WsB + (size_t)(w * 128 + tl0 + r) * 128 + 16 * ks + 8 * h);
#pragma unroll
        for (int dt = 0; dt < 2; ++dt) {
            LAS unsigned char* a0 = gs + (16 * ks + 8 * h + q) * GS_STRIDE + (w * 64 + 32 * dt + 16 * blk + 4 * p4) * 2;
            const s16x4 lo = vtr(a0), hi = vtr(a0 + 4 * GS_STRIDE);
            const bf16x8 ga = __builtin_shufflevector(lo, hi, 0, 1, 2, 3, 4, 5, 6, 7);
            Y[dt] = MFMA32(ga, wf, Y[dt]);
        }
    }
    const float bias = F.in[11][w * 128 + tl0 + r];
    float ss = 0.f;
#pragma unroll
    for (int dt = 0; dt < 2; ++dt)
#pragma unroll
        for (int g = 0; g < 4; ++g) { const u16x4 uu = *(const u16x4*)(Ub + (size_t)(g0 + r) * 512 + w * 64 + 32 * dt + 8 * g + 4 * h);
#pragma unroll
            for (int e = 0; e < 4; ++e) { const float v = bf2f(uu[e]) * (Y[dt][4 * g + e] + bias); Y[dt][4 * g + e] = v; ss += v * v; } }
    ss += __shfl_xor(ss, 32);
    if (h == 0) red[w * 32 + r] = ss;
    __syncthreads();
    float tot = 0.f;
#pragma unroll
    for (int ww = 0; ww < 8; ++ww) tot += red[ww * 32 + r];
    const float rn = rsqrtf(tot * (1.0f / 512.0f) + EPS);
    store_norm_tile(Y, rn, (bf16*)(F.ws + WS_A1) + (size_t)(g0 + r) * DM + 512 + w * 64, h);
    __syncthreads();
}

__device__ __forceinline__ void sample_unit(Frame& F, int b) {
    const int row = SEQ + b, w = F.wave, lane = F.lane, kvh = w >> 2;
    const bf16* Qb = (const bf16*)(F.ws + WS_QB); const bf16* Ub = (const bf16*)(F.ws + WS_UB);
    LAS float* qs = (LAS float*)F.lds + w * 64; LAS float* ps = (LAS float*)(F.lds + 2048) + w * 128; LAS float* red = (LAS float*)(F.lds + RED_OFF);
    qs[lane] = bf2f(Qb[(size_t)row * 512 + w * 64 + lane]);
    __syncthreads();
    const float* ck = F.in[2]; const float* cv = F.in[3];
    float s[2];
#pragma unroll
    for (int i = 0; i < 2; ++i) { const int sj = 1 + lane + 64 * i;
        const float* kp = sj < 128 ? ck + ((size_t)(b * 128 + sj) * 2 + kvh) * 64 : F.out + O_NKS + ((size_t)(b * 128 + 127) * 2 + kvh) * 64;
        float d = 0.f;
#pragma unroll
        for (int c = 0; c < 16; ++c) { const f32x4 kk = ((const f32x4*)kp)[c]; const f32x4 qq = ((LAS f32x4*)qs)[c]; d += (kk[0] * qq[0] + kk[1] * qq[1]) + (kk[2] * qq[2] + kk[3] * qq[3]); }
        s[i] = d * 0.125f; }
    const float sink = F.in[8][w];
    const float mx = fmaxf(wave_max(fmaxf(s[0], s[1])), sink);
    const float p0 = __expf(s[0] - mx), p1 = __expf(s[1] - mx);
    const float sum = wave_sum(p0 + p1) + __expf(sink - mx);
    ps[lane] = p0; ps[64 + lane] = p1;
    __syncthreads();
    float o = 0.f;
    for (int kk = 0; kk < 128; ++kk) { const int sj = kk + 1;
        const float* vp = sj < 128 ? cv + ((size_t)(b * 128 + sj) * 2 + kvh) * 64 : F.out + O_NVS + ((size_t)(b * 128 + 127) * 2 + kvh) * 64;
        o += ps[kk] * vp[lane]; }
    o /= sum;
    const float uu = bf2f(Ub[(size_t)row * 512 + w * 64 + lane]);
    const float gvv = F.out[O_NGV + (size_t)b * 512 + w * 64 + lane];
    const float gm = uu * (F.in[10][(size_t)w * 16384] * gvv + F.in[11][w * 128]);
    const float ssa = wave_sum(o * o), ssg = wave_sum(gm * gm);
    if (lane == 0) { red[w] = ssa; red[8 + w] = ssg; }
    __syncthreads();
    float ta = 0.f, tg2 = 0.f;
#pragma unroll
    for (int ww = 0; ww < 8; ++ww) { ta += red[ww]; tg2 += red[8 + ww]; }
    bf16* mix = (bf16*)(F.ws + WS_A1) + (size_t)row * DM;
    mix[w * 64 + lane] = (bf16)f2bf(o * rsqrtf(ta * (1.0f / 512.0f) + EPS));
    mix[512 + w * 64 + lane] = (bf16)f2bf(gm * rsqrtf(tg2 * (1.0f / 512.0f) + EPS));
    __syncthreads();
}

__device__ __forceinline__ int f2key(float f) { const int b = __builtin_bit_cast(int, f); return b ^ ((b >> 31) & 0x7fffffff); }
__device__ __forceinline__ float key2f(int k) { return __builtin_bit_cast(float, k ^ ((k >> 31) & 0x7fffffff)); }
__device__ __forceinline__ void ce_desc(int& a, int& b) { const int hi = a > b ? a : b, lo = a > b ? b : a; a = hi; b = lo; }
__device__ __forceinline__ void sort16_desc(int (&a)[16]) {
#pragma unroll
    for (int k = 2; k <= 16; k <<= 1)
#pragma unroll
        for (int j = k >> 1; j > 0; j >>= 1)
#pragma unroll
            for (int i = 0; i < 16; ++i) { const int l = i ^ j; if (l > i) { if ((i & k) == 0) ce_desc(a[i], a[l]); else ce_desc(a[l], a[i]); } }
}
__device__ __forceinline__ void merge16_desc(int (&a)[16], const int (&b)[16]) {
#pragma unroll
    for (int i = 0; i < 16; ++i) a[i] = a[i] > b[15 - i] ? a[i] : b[15 - i];
#pragma unroll
    for (int j = 8; j > 0; j >>= 1)
#pragma unroll
        for (int i = 0; i < 16; ++i) { const int l = i ^ j; if (l > i) ce_desc(a[i], a[l]); }
}

__device__ __forceinline__ void route_list(const unsigned char* qbase  , const unsigned char* kbase  , unsigned voffq, unsigned voffk, int (&out)[16]) {
    f32x16 acc[4];
#pragma unroll
    for (int mt = 0; mt < 4; ++mt)
#pragma unroll
        for (int i = 0; i < 16; ++i) acc[mt][i] = 0.f;
#pragma unroll 2
    for (int ks = 0; ks < 8; ++ks) {
        const bf16x8 bq = *(const bf16x8*)(qbase + ks * 32 + voffq);
#pragma unroll
        for (int mt = 0; mt < 4; ++mt) { const bf16x8 ak = *(const bf16x8*)(kbase + mt * 8192 + ks * 32 + voffk); acc[mt] = MFMA32(ak, bq, acc[mt]); }
    }
    int k1[16];
#pragma unroll
    for (int i = 0; i < 16; ++i) { out[i] = (f2key(acc[0][i]) & ~127) | (crow(i, 0)); k1[i] = (f2key(acc[1][i]) & ~127) | (32 + crow(i, 0)); }
    sort16_desc(out); sort16_desc(k1); merge16_desc(out, k1);
    int k2[16];
#pragma unroll
    for (int i = 0; i < 16; ++i) { k2[i] = (f2key(acc[2][i]) & ~127) | (64 + crow(i, 0)); k1[i] = (f2key(acc[3][i]) & ~127) | (96 + crow(i, 0)); }
    sort16_desc(k2); sort16_desc(k1); merge16_desc(k2, k1); merge16_desc(out, k2);
}

__device__ __forceinline__ void route_task(Frame& F, int tg, int hp) {
    const int lane = F.lane, r = lane & 31, h = lane >> 5, w = F.wave;
    const int token = 32 * tg + r;
    const unsigned char* QPu = F.ws + WS_QP + ((size_t)(32 * tg) * NQ + (2 * hp) * 256) * 2;
    const unsigned char* SKu = F.ws + WS_SK + (size_t)((2 * hp) * 2 * 128) * 128 * 2;
    const unsigned voffq = (unsigned)(r * NQ + 8 * h) * 2u, voffk = (unsigned)(r * 128 + 8 * h) * 2u;
    const int h4 = 4 * h;
    int T[2][16];
#pragma unroll
    for (int p = 0; p < 2; ++p) {
        int La[16], Lb[16];
        route_list(QPu + p * 256, SKu + p * 32768, voffq, voffk, La);
        __builtin_amdgcn_sched_barrier(0);
        route_list(QPu + 512 + p * 256, SKu + 65536 + p * 32768, voffq, voffk, Lb);
        __builtin_amdgcn_sched_barrier(0);
        int other[16];
#pragma unroll
        for (int i = 0; i < 16; ++i) { const int send = h ? La[i] : Lb[i]; other[i] = __shfl_xor(send, 32) | (4 - h4); T[p][i] = (h ? Lb[i] : La[i]) | h4; }
        merge16_desc(T[p], other);
        __builtin_amdgcn_sched_barrier(0);
    }
    const int head = 2 * hp + h;
    float v1[16], v2[16];
#pragma unroll
    for (int i = 0; i < 16; ++i) { v1[i] = key2f(T[0][i]); v2[i] = key2f(T[1][i]); }
    int c0[16], c1[16], c2[16], c3[16];
    {
        int n = 0;
#pragma unroll
        for (int i = 0; i < 16; ++i)
#pragma unroll
            for (int j = 0; j < 16; ++j) if ((i + 1) * (j + 1) <= 16) {
                const int key = (f2key(v1[i] + v2[j]) & ~255) | (i * 16 + j);
                if (n < 16) c0[n] = key; else if (n < 32) c1[n - 16] = key; else if (n < 48) c2[n - 32] = key; else c3[n - 48] = key;
                ++n;
            }
#pragma unroll
        for (int t = 2; t < 16; ++t) c3[t] = (int)0x80000000;
    }
    sort16_desc(c0); sort16_desc(c1); sort16_desc(c2); sort16_desc(c3);
    merge16_desc(c0, c1); merge16_desc(c2, c3); merge16_desc(c0, c2);
    LAS unsigned* ib = (LAS unsigned*)(F.lds + w * 2048 + lane * 32);
#pragma unroll
    for (int p = 0; p < 2; ++p)
#pragma unroll
        for (int d = 0; d < 4; ++d) ib[p * 4 + d] = (unsigned)(T[p][4 * d] & 127) | ((unsigned)(T[p][4 * d + 1] & 127) << 8) | ((unsigned)(T[p][4 * d + 2] & 127) << 16) | ((unsigned)(T[p][4 * d + 3] & 127) << 24);
    float best[16]; int ex[16];
    LAS unsigned char* ibb = (LAS unsigned char*)ib;
#pragma unroll
    for (int k = 0; k < 16; ++k) { best[k] = key2f(c0[k]); const int tag = c0[k] & 255; ex[k] = (int)ibb[tag >> 4] * 128 + (int)ibb[16 + (tag & 15)]; }
    float den = 0.f;
#pragma unroll
    for (int k = 0; k < 16; ++k) { best[k] = __expf(best[k] - key2f(c0[0])); den += best[k]; }
    const float rd = 1.0f / den;
    if (token < MTOK) {
        u32x4* dst = (u32x4*)(F.ws + WS_ROUTE + ((size_t)token * 128 + head * 16) * 8);
#pragma unroll
        for (int k = 0; k < 16; k += 2) dst[k >> 1] = (u32x4){(unsigned)ex[k], __builtin_bit_cast(unsigned, best[k] * rd), (unsigned)ex[k + 1], __builtin_bit_cast(unsigned, best[k + 1] * rd)};
    }
}

__device__ __forceinline__ void gather_token(Frame& F, int token) {
    const int lane = F.lane;
    float* hrow = F.out + (size_t)token * DM;
    const bf16* EU = (const bf16*)(F.ws + WS_EU); const bf16* EV = (const bf16*)(F.ws + WS_EV);
    float x[16], hv[16];
    float ss = 0.f;
#pragma unroll
    for (int jj = 0; jj < 2; ++jj) { const f32x4 a = *(const f32x4*)(hrow + 512 * jj + 8 * lane), b = *(const f32x4*)(hrow + 512 * jj + 8 * lane + 4);
#pragma unroll
        for (int e = 0; e < 4; ++e) { hv[8 * jj + e] = a[e]; hv[8 * jj + 4 + e] = b[e]; } }
#pragma unroll
    for (int i = 0; i < 16; ++i) ss += hv[i] * hv[i];
    const float r2 = rsqrtf(wave_sum(ss) * (1.0f / DM) + EPS);
    const float* nfw = F.in[14];
#pragma unroll
    for (int jj = 0; jj < 2; ++jj) { const f32x4 a = *(const f32x4*)(nfw + 512 * jj + 8 * lane), b = *(const f32x4*)(nfw + 512 * jj + 8 * lane + 4);
#pragma unroll
        for (int e = 0; e < 4; ++e) { x[8 * jj + e] = hv[8 * jj + e] * r2 * a[e]; x[8 * jj + 4 + e] = hv[8 * jj + 4 + e] * r2 * b[e]; } }
    const i32x2* rt = (const i32x2*)(F.ws + WS_ROUTE + (size_t)token * 128 * 8);
    const i32x2 e0 = rt[lane], e1 = rt[64 + lane];
    float acc[16];
#pragma unroll
    for (int i = 0; i < 16; ++i) acc[i] = 0.f;
    for (int n0 = 0; n0 < 128; n0 += 8) {
        int eid[8]; float gg[8];
#pragma unroll
        for (int t = 0; t < 8; ++t) { const int n = n0 + t; const i32x2 src = n0 < 64 ? e0 : e1;
            eid[t] = __builtin_amdgcn_readlane(src.x, n & 63); gg[t] = __builtin_bit_cast(float, __builtin_amdgcn_readlane(src.y, n & 63)); }
        u32x4 ur[8][2];
#pragma unroll
        for (int t = 0; t < 8; ++t) { const bf16* up = EU + (size_t)eid[t] * DM + 8 * lane; ur[t][0] = *(const u32x4*)up; ur[t][1] = *(const u32x4*)(up + 512); }
        float wg[8];
#pragma unroll
        for (int t = 0; t < 8; ++t) { float d = 0.f;
#pragma unroll
            for (int jj = 0; jj < 2; ++jj)
#pragma unroll
                for (int c = 0; c < 4; ++c) { const unsigned wv = ur[t][jj][c]; d += bflo(wv) * x[8 * jj + 2 * c] + bfhi(wv) * x[8 * jj + 2 * c + 1]; }
            d = wave_sum(d);
            wg[t] = gg[t] * gelu1(d); }
#pragma unroll
        for (int t = 0; t < 8; ++t) { const bf16* vp = EV + (size_t)eid[t] * DM + 8 * lane; ur[t][0] = *(const u32x4*)vp; ur[t][1] = *(const u32x4*)(vp + 512); }
#pragma unroll
        for (int t = 0; t < 8; ++t)
#pragma unroll
            for (int jj = 0; jj < 2; ++jj)
#pragma unroll
                for (int c = 0; c < 4; ++c) { const unsigned wv = ur[t][jj][c]; acc[8 * jj + 2 * c] += wg[t] * bflo(wv); acc[8 * jj + 2 * c + 1] += wg[t] * bfhi(wv); }
    }
#pragma unroll
    for (int jj = 0; jj < 2; ++jj) {
        *(f32x4*)(hrow + 512 * jj + 8 * lane) = (f32x4){hv[8 * jj] + acc[8 * jj], hv[8 * jj + 1] + acc[8 * jj + 1], hv[8 * jj + 2] + acc[8 * jj + 2], hv[8 * jj + 3] + acc[8 * jj + 3]};
        *(f32x4*)(hrow + 512 * jj + 8 * lane + 4) = (f32x4){hv[8 * jj + 4] + acc[8 * jj + 4], hv[8 * jj + 5] + acc[8 * jj + 5], hv[8 * jj + 6] + acc[8 * jj + 6], hv[8 * jj + 7] + acc[8 * jj + 7]};
    }
}

namespace cg = cooperative_groups;
constexpr int NPHASE = 7;
#ifndef SKIPMASK
#define SKIPMASK 0
#endif
#ifndef MK_BAR_KIND
#define MK_BAR_KIND 2
#endif

__global__ void __launch_bounds__(NWAVES * 64, 2) mk_fwd(Args args) {
    extern __shared__ __attribute__((aligned(16))) unsigned char lds_raw[];
    Frame F;
    F.lds = (LAS unsigned char*)lds_raw;
    F.tid = threadIdx.x; F.lane = F.tid & 63; F.wave = __builtin_amdgcn_readfirstlane(F.tid >> 6);
    F.G = gridDim.x; F.bid = blockIdx.x;
    F.in = args.in; F.out = args.out; F.ws = args.ws;
    volatile LAS unsigned* MISC = (volatile LAS unsigned*)(F.lds + MISC_OFF);
    for (int u = F.tid; u < (LDS_BYTES - MISC_OFF) / 4; u += NWAVES * 64) ((LAS unsigned*)(F.lds + MISC_OFF))[u] = 0u;
    __syncthreads();
    XcdBarrier bar; bar.bar = (unsigned*)(F.ws + WS_CTL) + CW_BAR; bar.x = 0; bar.st = nullptr;
    if (args.use_bar == 2) bar = xcd_barrier_post((unsigned*)(F.ws + WS_CTL) + CW_BAR, MISC + 8);
    const int lo = args.ph_lo, hi = args.ph_hi;
#define IN(k) (lo <= (k) && (k) < hi)
#define SEAM(k) do { if (IN(k) && IN((k) + 1)) { if (args.use_bar == 2) xcd_barrier(bar); else cg::this_grid().sync(); } } while (0)

    if (IN(0) && !(SKIPMASK & 1)) { p0_prologue(F); }
    SEAM(0);
    if (IN(1) && !(SKIPMASK & 2)) {
        pg8::Gemm g{(const pg8::bf16_t*)(F.ws + WS_A0), (const pg8::bf16_t*)(F.ws + WS_WIN), MP, DIN, DM}; pg8::StaticOrder S; S.init(MP, DIN, F.G, F.bid);
        EpiIn E{(bf16*)(F.ws + WS_QB), (bf16*)(F.ws + WS_KB), (bf16*)(F.ws + WS_VB), (bf16*)(F.ws + WS_UB), (bf16*)(F.ws + WS_GVB), (const float*)(F.ws + WS_ROPE), F.in[6], F.in[7], F.in[9], F.out};
        pg8::gemm_phase<EpiIn, pg8::StaticOrder, true, true>(F.lds, g, S, E);
    }
    SEAM(1);
    if (IN(2) && !(SKIPMASK & 4)) {
        constexpr int NU = 512 + 512 + NSMP;
        for (int u = F.bid; u < NU; u += F.G) {
            if (u < 512) gate_unit(F, (u & ~3) | (3 - (u & 3)));
            else if (u < 1024) attn_unit(F, u - 512);
            else sample_unit(F, u - 1024);
        }
    }
    SEAM(2);
    if (IN(3) && !(SKIPMASK & 8)) {
        pg8::Gemm g{(const pg8::bf16_t*)(F.ws + WS_A1), (const pg8::bf16_t*)(F.ws + WS_WO), MP, DM, DM}; pg8::StaticOrder S; S.init(MP, DM, F.G, F.bid);
        EpiOut E{F.in[0], F.in[1], F.out, (bf16*)(F.ws + WS_A0), (float*)(F.ws + WS_ROWSS)};
        pg8::gemm_phase<EpiOut, pg8::StaticOrder, true, true>(F.lds, g, S, E);
    }
    SEAM(3);
    if (IN(4) && !(SKIPMASK & 16)) {
        pg8::Gemm g{(const pg8::bf16_t*)(F.ws + WS_A0), (const pg8::bf16_t*)(F.ws + WS_WQ), MP, NQ, DM}; pg8::StaticOrder S; S.init(MP, NQ, F.G, F.bid);
        EpiQ E{(bf16*)(F.ws + WS_QP), (const float*)(F.ws + WS_ROWSS)};
        pg8::gemm_phase<EpiQ, pg8::StaticOrder, true, true>(F.lds, g, S, E);
    }
    SEAM(4);
    if (IN(5) && !(SKIPMASK & 32)) {
        const int gw = F.bid * NWAVES + F.wave, NGW = F.G * NWAVES;
        for (int t = gw; t < (MP / 32) * 4; t += NGW) route_task(F, t >> 2, t & 3);
    }
    SEAM(5);
    if (IN(6) && !(SKIPMASK & 64)) {
        const int gw = F.bid * NWAVES + F.wave, NGW = F.G * NWAVES;
        for (int t = gw; t < MTOK; t += NGW) gather_token(F, t);
    }
#undef IN
#undef SEAM
}

#ifndef MK_N_LAUNCHES
#define MK_N_LAUNCHES 1
#endif
extern "C" void kernel_launch(void* const* d_in, const int* in_sizes, int n_in, void* d_out, int out_size, void* d_ws, size_t ws_size, hipStream_t stream) {
    static int grid = 0;
    if (grid == 0) {
        if (n_in != 19 || out_size != (int)O_END || ws_size < WS_END) { fprintf(stderr, "kernel_launch: unexpected shapes (n_in %d out %d ws %zu)\n", n_in, out_size, ws_size); grid = -1; return; }
        int dev = 0, cus = 0, per_cu = 0;
        hipGetDevice(&dev); hipDeviceGetAttribute(&cus, hipDeviceAttributeMultiprocessorCount, dev);
        if (hipFuncSetAttribute((const void*)mk_fwd, hipFuncAttributeMaxDynamicSharedMemorySize, LDS_BYTES) != hipSuccess) { fprintf(stderr, "kernel_launch: hipFuncSetAttribute failed\n"); grid = -1; return; }
        if (hipOccupancyMaxActiveBlocksPerMultiprocessor(&per_cu, (const void*)mk_fwd, NWAVES * 64, LDS_BYTES) != hipSuccess || per_cu < 1) { fprintf(stderr, "kernel_launch: occupancy query says %d\n", per_cu); }
        (void)hipGetLastError();
        grid = cus;
    }
    if (grid < 0) return;
    hipMemsetAsync((char*)d_ws + WS_CTL, 0, CTL_ZERO_BYTES, stream);
    Args a{};
    for (int i = 0; i < 19; ++i) a.in[i] = (const float*)d_in[i];
    a.out = (float*)d_out; a.ws = (unsigned char*)d_ws;
#if MK_N_LAUNCHES == 1
    a.ph_lo = 0; a.ph_hi = NPHASE; a.use_bar = MK_BAR_KIND;
    void* kargs[] = {&a};
    hipError_t e = hipLaunchCooperativeKernel((const void*)mk_fwd, dim3(grid), dim3(NWAVES * 64), kargs, LDS_BYTES, stream);
    if (e != hipSuccess) fprintf(stderr, "cooperative launch failed: %s (grid %d)\n", hipGetErrorString(e), grid);
#else
    for (int li = 0; li < NPHASE; ++li) {
        a.ph_lo = li; a.ph_hi = li + 1; a.use_bar = 0;
        hipLaunchKernelGGL(mk_fwd, dim3(grid), dim3(NWAVES * 64), LDS_BYTES, stream, a);
    }
#endif
}
```

```cpp
#include <hip/hip_runtime.h>
#include <hip/hip_cooperative_groups.h>
#include <cstdio>
#include <cstdint>
namespace pg8 {
#define PG8_LAS __attribute__((address_space(3)))
typedef unsigned short bf16_t;
typedef short bf16x8 __attribute__((ext_vector_type(8)));
typedef float f32x4 __attribute__((ext_vector_type(4)));
typedef unsigned u32x4 __attribute__((ext_vector_type(4)));
constexpr int BM = 256, BK = 64, HALF = 128, HTB = HALF * BK * 2  , STAGE_BYTES = 8 * HTB, NXCD = 8, WGM = 8;

__host__ __device__ __forceinline__ int lds_byte(int r, int c) { const int st = (r >> 4) * 2 + (c >> 5), rr = r & 15, cc = c & 31, ob = rr * 64 + cc * 2; return st * 1024 + (ob ^ (((ob >> 9) & 1) << 5)); }
__host__ __device__ __forceinline__ void stage_rc(int b, int& R, int& C) { const int st = b / 1024, sb = b % 1024, swz = sb ^ (((sb >> 9) & 1) << 5); R = (st >> 1) * 16 + swz / 64; C = (st & 1) * 32 + (swz % 64) / 2; }
__host__ __device__ __forceinline__ int perm32(int rho) { const int n = rho >> 4, i = rho & 15; return 8 * (i >> 2) + 4 * n + (i & 3); }

struct Unit { int pm, pn; };
struct Gemm { const bf16_t* A; const bf16_t* Bt; int M, N, K; };

struct StaticOrder {
    int nM, nN, nwg, G, c;
    __host__ __device__ void init(int M, int N, int G_, int c_) { nM = M / BM; nN = N / BM; nwg = nM * nN; G = G_; c = c_; }
    __host__ __device__ bool next(int i, Unit& u) const {
        const long L = (long)i * G + c; if (L >= nwg) return false;
        int wgid = (int)L; { const int q = nwg / NXCD, r = nwg % NXCD, xcd = wgid % NXCD, off = wgid / NXCD; wgid = (xcd < r ? xcd * (q + 1) : r * (q + 1) + (xcd - r) * q) + off; }
        const int nig = WGM * nN, gid = wgid / nig, fm = gid * WGM, gsz = (nM - fm) < WGM ? (nM - fm) : WGM;
        u.pm = fm + ((wgid % nig) % gsz); u.pn = (wgid % nig) / gsz; return true;
    }
    __device__ __forceinline__ void a_ready(const Unit&) const {}
    __device__ __forceinline__ void done(const Unit&) const {}
};

__device__ __forceinline__ unsigned cvt_pk_bf16(float lo, float hi) { unsigned r; asm volatile("v_cvt_pk_bf16_f32 %0, %1, %2" : "=v"(r) : "v"(lo), "v"(hi)); return r; }
typedef float f32x2 __attribute__((ext_vector_type(2)));
__device__ __forceinline__ f32x2 gelu_pk(f32x2 v) {
    const f32x2 av = __builtin_elementwise_abs(v), d = av * 0.2316418882f + 1.0f;
    f32x2 t; t.x = __builtin_amdgcn_rcpf(d.x); t.y = __builtin_amdgcn_rcpf(d.y);
    f32x2 q = t * 0.5307027145f + (-0.7265760135f); q = q * t + 0.7107068705f; q = q * t + (-0.142248368f); q = q * t + 0.127414796f; q = q * t;
    const f32x2 s = (v * v) * (-0.72134752044f);
    f32x2 e; e.x = __builtin_amdgcn_exp2f(s.x); e.y = __builtin_amdgcn_exp2f(s.y);
    const f32x2 m = v * (q * e), r = v - m;
    f32x2 o; o.x = v.x < 0.f ? m.x : r.x; o.y = v.y < 0.f ? m.y : r.y; return o;
}
template <class Epi, class Sched, bool ALIGN_EPI = false, bool SP2 = false>
__device__ __forceinline__ void gemm_phase(PG8_LAS unsigned char* lds, const Gemm g, const Sched& S, const Epi& E) {
    const int tid = threadIdx.x, wid = __builtin_amdgcn_readfirstlane(tid >> 6), lane = tid & 63, wr = wid >> 2, wc = wid & 3, fr = lane & 15, fq = lane >> 4;
    const int K = g.K, nt = K / BK;
    unsigned voffA[2], voffB[2];
#pragma unroll
    for (int i = 0; i < 2; ++i) { int R, C; stage_rc(tid * 16 + i * 8192, R, C); const int Rb = Epi::PERM ? ((R & ~31) + perm32(R & 31)) : R;
        voffA[i] = (unsigned)(R * K + C) * 2u; voffB[i] = (unsigned)(Rb * K + C) * 2u; }
    const size_t kstep = (size_t)(BK * 2);
    const size_t hstep = (size_t)HALF * K * 2;
    const size_t tstep = 2 * hstep;
    const unsigned ldsw = (unsigned)wid * 1024u;
    const int aoff = lds_byte(wr * 64 + fr, fq * 8), boff = lds_byte(wc * 32 + fr, fq * 8);
#define PG8_SA(b, h) (((b) * 2 + (h)) * HTB)
#define PG8_SB(b, h) ((4 + (b) * 2 + (h)) * HTB)
#define PG8_STAGE(bufoff, gbase, voff) do { _Pragma("unroll") for (int _i = 0; _i < 2; ++_i) \
        __builtin_amdgcn_global_load_lds((const unsigned*)((const char*)(gbase) + (voff)[_i]), (PG8_LAS unsigned*)(lds + (bufoff) + ldsw + _i * 8192), 16, 0, 0); } while (0)
#define PG8_LDA(dst, b, h) do { _Pragma("unroll") for (int m = 0; m < 4; ++m) _Pragma("unroll") for (int k = 0; k < 2; ++k) dst[m][k] = *(const PG8_LAS bf16x8*)(lds + PG8_SA(b, h) + aoff + m * 2048 + k * 1024); } while (0)
#define PG8_LDB(dst, b, h) do { _Pragma("unroll") for (int n = 0; n < 2; ++n) _Pragma("unroll") for (int k = 0; k < 2; ++k) dst[n][k] = *(const PG8_LAS bf16x8*)(lds + PG8_SB(b, h) + boff + n * 2048 + k * 1024); } while (0)
#define PG8_MMA(ai, bj, At, Bt) do { __builtin_amdgcn_s_setprio(1); _Pragma("unroll") for (int m = 0; m < 4; ++m) _Pragma("unroll") for (int n = 0; n < 2; ++n) _Pragma("unroll") for (int k = 0; k < 2; ++k) \
        acc[ai][bj][m][n] = __builtin_amdgcn_mfma_f32_16x16x32_bf16(Bt[n][k], At[m][k], acc[ai][bj][m][n], 0, 0, 0); __builtin_amdgcn_s_setprio(0); } while (0)
#define PG8_WAIT_V(n) asm volatile("s_waitcnt vmcnt(" #n ")" ::: "memory")
#define PG8_WAIT_L(n) asm volatile("s_waitcnt lgkmcnt(" #n ")" ::: "memory")
#define PG8_BAR __builtin_amdgcn_s_barrier()
#define PG8_SCHED __builtin_amdgcn_sched_barrier(0)
    Unit cur, nxt; int ui = 0;
    if (!S.next(0, cur)) return;
    f32x4 acc[2][2][4][2];
#pragma unroll
    for (int a = 0; a < 2; ++a)
#pragma unroll
        for (int b = 0; b < 2; ++b)
#pragma unroll
            for (int m = 0; m < 4; ++m)
#pragma unroll
                for (int n = 0; n < 2; ++n) acc[a][b][m][n] = (f32x4){0.f, 0.f, 0.f, 0.f};
    bf16x8 At[4][2], B0[2][2], B1[2][2];
    const char* cA = (const char*)g.A + (size_t)cur.pm * tstep; const char* cB = (const char*)g.Bt + (size_t)cur.pn * tstep;
    S.a_ready(cur);
    if constexpr (SP2) {
        PG8_STAGE(PG8_SB(0, 0), cB, voffB); PG8_STAGE(PG8_SB(0, 1), cB + hstep, voffB); PG8_STAGE(PG8_SA(0, 0), cA, voffA); PG8_STAGE(PG8_SA(0, 1), cA + hstep, voffA);
        if (wr == 1) PG8_BAR;
        PG8_WAIT_V(2); PG8_BAR;
        PG8_STAGE(PG8_SB(1, 0), cB + kstep, voffB); PG8_STAGE(PG8_SA(1, 0), cA + kstep, voffA); PG8_STAGE(PG8_SB(1, 1), cB + hstep + kstep, voffB);
        PG8_WAIT_V(6); PG8_BAR;
    } else {
        PG8_STAGE(PG8_SB(0, 0), cB, voffB); PG8_STAGE(PG8_SA(0, 0), cA, voffA); PG8_STAGE(PG8_SB(0, 1), cB + hstep, voffB); PG8_STAGE(PG8_SA(0, 1), cA + hstep, voffA);
        if (wr == 1) PG8_BAR;
        PG8_WAIT_V(4); PG8_BAR;
        PG8_STAGE(PG8_SB(1, 0), cB + kstep, voffB); PG8_STAGE(PG8_SA(1, 0), cA + kstep, voffA); PG8_STAGE(PG8_SB(1, 1), cB + hstep + kstep, voffB);
        PG8_WAIT_V(6); PG8_BAR;
    }
    for (;;) {
        const bool has_next = S.next(ui + 1, nxt);
        const char* nA = has_next ? (const char*)g.A + (size_t)nxt.pm * tstep : cA; const char* nB = has_next ? (const char*)g.Bt + (size_t)nxt.pn * tstep : cB;
        for (int t = 0; t < nt; t += 2) {
            const bool last = (t == nt - 2);
            const char* a1 = cA + (size_t)(t + 1) * kstep;
            const char* a2 = last ? nA : cA + (size_t)(t + 2) * kstep; const char* b2 = last ? nB : cB + (size_t)(t + 2) * kstep;
            const char* a3 = a2 + kstep; const char* b3 = b2 + kstep;
            if (last && has_next) S.a_ready(nxt);
            if constexpr (SP2) {
            PG8_LDB(B0, 0, 0); PG8_LDB(B1, 0, 1); PG8_SCHED; PG8_LDA(At, 0, 0); PG8_STAGE(PG8_SA(1, 1), a1 + hstep, voffA);
            PG8_WAIT_V(8); PG8_WAIT_L(0); PG8_BAR; PG8_MMA(0, 0, At, B0); PG8_MMA(0, 1, At, B1); PG8_BAR; PG8_SCHED;
            PG8_LDA(At, 0, 1); PG8_STAGE(PG8_SB(0, 0), b2, voffB); PG8_STAGE(PG8_SB(0, 1), b2 + hstep, voffB); PG8_STAGE(PG8_SA(0, 0), a2, voffA);
            PG8_WAIT_V(8); PG8_WAIT_L(0); PG8_BAR; PG8_MMA(1, 0, At, B0); PG8_MMA(1, 1, At, B1); PG8_BAR; PG8_SCHED;
            PG8_LDB(B0, 1, 0); PG8_LDB(B1, 1, 1); PG8_SCHED; PG8_LDA(At, 1, 0); PG8_STAGE(PG8_SA(0, 1), a2 + hstep, voffA);
            PG8_WAIT_V(8); PG8_WAIT_L(0); PG8_BAR; PG8_MMA(0, 0, At, B0); PG8_MMA(0, 1, At, B1); PG8_BAR; PG8_SCHED;
            PG8_LDA(At, 1, 1); PG8_STAGE(PG8_SB(1, 0), b3, voffB); PG8_STAGE(PG8_SB(1, 1), b3 + hstep, voffB); PG8_STAGE(PG8_SA(1, 0), a3, voffA);
            PG8_WAIT_V(8); PG8_WAIT_L(0); PG8_BAR; PG8_MMA(1, 0, At, B0); PG8_MMA(1, 1, At, B1); PG8_BAR; PG8_SCHED;
            } else {
            PG8_LDB(B0, 0, 0); PG8_SCHED; PG8_LDA(At, 0, 0); PG8_STAGE(PG8_SA(1, 1), a1 + hstep, voffA);
            PG8_WAIT_L(8); PG8_BAR; PG8_WAIT_L(0); PG8_MMA(0, 0, At, B0); PG8_BAR; PG8_SCHED;
            PG8_LDB(B1, 0, 1); PG8_STAGE(PG8_SB(0, 0), b2, voffB);
            PG8_BAR; PG8_WAIT_L(0); PG8_MMA(0, 1, At, B1); PG8_BAR;
            PG8_LDA(At, 0, 1); PG8_STAGE(PG8_SA(0, 0), a2, voffA);
            PG8_BAR; PG8_WAIT_L(0); PG8_MMA(1, 0, At, B0); PG8_BAR; PG8_SCHED;
            PG8_STAGE(PG8_SB(0, 1), b2 + hstep, voffB);
            PG8_WAIT_V(6); PG8_BAR; PG8_MMA(1, 1, At, B1); PG8_BAR;
            PG8_LDB(B0, 1, 0); PG8_SCHED; PG8_LDA(At, 1, 0); PG8_STAGE(PG8_SA(0, 1), a2 + hstep, voffA);
            PG8_WAIT_L(8); PG8_BAR; PG8_WAIT_L(0); PG8_MMA(0, 0, At, B0); PG8_BAR; PG8_SCHED;
            PG8_LDB(B1, 1, 1); PG8_STAGE(PG8_SB(1, 0), b3, voffB);
            PG8_BAR; PG8_WAIT_L(0); PG8_MMA(0, 1, At, B1); PG8_BAR;
            PG8_LDA(At, 1, 1); PG8_STAGE(PG8_SA(1, 0), a3, voffA);
            PG8_BAR; PG8_WAIT_L(0); PG8_MMA(1, 0, At, B0); PG8_BAR; PG8_SCHED;
            PG8_STAGE(PG8_SB(1, 1), b3 + hstep, voffB);
            PG8_WAIT_V(6); PG8_BAR; PG8_MMA(1, 1, At, B1); PG8_BAR;
            }
        }
        if constexpr (ALIGN_EPI) { if (wr == 0) PG8_BAR; }
        if constexpr (!Epi::AFTER_DRAIN) { E(acc, cur, wr, wc, fr, fq); S.done(cur); }
        if (!has_next) break;
#pragma unroll
        for (int a = 0; a < 2; ++a)
#pragma unroll
            for (int b = 0; b < 2; ++b)
#pragma unroll
                for (int m = 0; m < 4; ++m)
#pragma unroll
                    for (int n = 0; n < 2; ++n) acc[a][b][m][n] = (f32x4){0.f, 0.f, 0.f, 0.f};
        cur = nxt; cA = nA; cB = nB; ++ui;
        if constexpr (ALIGN_EPI) { if (wr == 1) PG8_BAR; }
    }
    PG8_WAIT_V(0);
    if constexpr (!ALIGN_EPI) { if (wr == 0) PG8_BAR; }
    PG8_BAR;
    if constexpr (Epi::AFTER_DRAIN) { E.fused(acc, cur, wr, wc, fr, fq, lds, wid, lane); S.done(cur); }
#undef PG8_SA
#undef PG8_SB
#undef PG8_STAGE
#undef PG8_LDA
#undef PG8_LDB
#undef PG8_MMA
#undef PG8_WAIT_V
#undef PG8_WAIT_L
#undef PG8_BAR
#undef PG8_SCHED
}
}

constexpr int DM = 1024, SEQ = 16384, NSMP = 128, MTOK = SEQ + NSMP  , MP = 16640  ;
constexpr int DIN = 1792, NQ = 2048, NEXP = 16384;
constexpr float EPS = 1e-6f;
constexpr int NWAVES = 8;

#define GAS __attribute__((address_space(1)))
#define LAS __attribute__((address_space(3)))
typedef unsigned short bf16;
typedef unsigned u32x4 __attribute__((ext_vector_type(4)));
typedef unsigned u32x2 __attribute__((ext_vector_type(2)));
typedef float f32x4 __attribute__((ext_vector_type(4)));
typedef float f32x2 __attribute__((ext_vector_type(2)));
typedef float f32x16 __attribute__((ext_vector_type(16)));
typedef short bf16x8 __attribute__((ext_vector_type(8)));
typedef short s16x4 __attribute__((ext_vector_type(4)));
typedef unsigned short u16x4 __attribute__((ext_vector_type(4)));
typedef int i32x2 __attribute__((ext_vector_type(2)));
typedef __bf16 bf16x2_t __attribute__((ext_vector_type(2)));

constexpr size_t MiB = 1u << 20;
constexpr size_t WS_CTL = 0, CTL_ZERO_BYTES = 1 * MiB;
constexpr size_t WS_WIN = 1 * MiB;
constexpr size_t WS_WO = 5 * MiB;
constexpr size_t WS_WQ = 7 * MiB;
constexpr size_t WS_SK = 11 * MiB;
constexpr size_t WS_WSB = 11 * MiB + 512 * 1024;
constexpr size_t WS_ROWSS = 12 * MiB;
constexpr size_t WS_ROPE = 14 * MiB;
constexpr size_t WS_EU = 20 * MiB;
constexpr size_t WS_EV = 52 * MiB;
constexpr size_t WS_A0 = 84 * MiB;
constexpr size_t WS_A1 = 117 * MiB;
constexpr size_t WS_QB = 150 * MiB;
constexpr size_t WS_KB = 167 * MiB;
constexpr size_t WS_VB = 172 * MiB;
constexpr size_t WS_UB = 177 * MiB;
constexpr size_t WS_GVB = 194 * MiB;
constexpr size_t WS_QP = 150 * MiB;
constexpr size_t WS_PART = 150 * MiB;
constexpr size_t WS_RID = 216 * MiB;
constexpr size_t WS_RG = 221 * MiB;
constexpr size_t WS_RW = 230 * MiB;
constexpr size_t WS_ROUTE = 216 * MiB;
constexpr size_t WS_END = 256 * MiB;
static_assert(WS_A0 + (size_t)MP * DM * 2 <= WS_A1 && WS_A1 + (size_t)MP * DM * 2 <= WS_QB && WS_QP + (size_t)MP * NQ * 2 <= WS_ROUTE && WS_RW + (size_t)MTOK * 128 * 4 <= WS_END && WS_RID + (size_t)MTOK * 128 * 2 <= WS_RG && WS_RG + (size_t)MTOK * 128 * 4 <= WS_RW && WS_PART + (size_t)8 * MTOK * 128 * 4 <= WS_ROUTE, "ws map");
static_assert(WS_GVB + (size_t)MP * 512 * 2 <= WS_ROUTE && WS_ROPE + (size_t)16385 * 64 * 4 <= WS_EU && WS_ROWSS + (size_t)16 * MP * 4 <= WS_ROPE, "ws map 2");

constexpr size_t O_Y = 0, O_NKP = 16908288, O_NVP = 16924672, O_NKS = 16941056, O_NVS = 19038208, O_NGV = 21135360, O_END = 21200896;

constexpr int CW_BAR = 4096;

constexpr int SCR_BYTES = 147456;
constexpr int MISC_OFF = SCR_BYTES;
constexpr int LDS_BYTES = SCR_BYTES + 1024;

__device__ __forceinline__ unsigned f2bf(float f) { unsigned u = __builtin_bit_cast(unsigned, f); return (u + 0x7fffu + ((u >> 16) & 1u)) >> 16; }
__device__ __forceinline__ unsigned pk2(float lo, float hi) { f32x2 v = {lo, hi}; bf16x2_t b = __builtin_convertvector(v, bf16x2_t); return __builtin_bit_cast(unsigned, b); }
__device__ __forceinline__ float bf2f(unsigned short b) { return __builtin_bit_cast(float, (unsigned)b << 16); }
__device__ __forceinline__ float bflo(unsigned w) { return __builtin_bit_cast(float, w << 16); }
__device__ __forceinline__ float bfhi(unsigned w) { return __builtin_bit_cast(float, w & 0xffff0000u); }
__device__ __forceinline__ float wave_sum(float v) {
#pragma unroll
    for (int o = 1; o < 64; o <<= 1) v += __shfl_xor(v, o);
    return v;
}
__device__ __forceinline__ float wave_max(float v) {
#pragma unroll
    for (int o = 1; o < 64; o <<= 1) v = fmaxf(v, __shfl_xor(v, o));
    return v;
}
__device__ __forceinline__ int crow(int reg, int h) { return (reg & 3) + 8 * (reg >> 2) + 4 * h; }
__device__ __forceinline__ float gelu1(float v) { f32x2 r = pg8::gelu_pk((f32x2){v, v}); return r.x; }
#define MFMA32(a, b, c) __builtin_amdgcn_mfma_f32_32x32x16_bf16((a), (b), (c), 0, 0, 0)
typedef short v4i16_t __attribute__((ext_vector_type(4)));
__device__ __forceinline__ s16x4 vtr(LAS unsigned char* p) { return __builtin_bit_cast(s16x4, __builtin_amdgcn_ds_read_tr16_b64_v4i16((LAS v4i16_t*)p)); }

#define XB_TMO      128
#define XB_XCNT(j)  (256  + 64 * (j))
#define XB_XSUB(j)  (1280 + 64 * (j))
#define XB_XGEN(j)  (2304 + 64 * (j))
#define XB_TOP      3328
#define XB_TOPGEN   3392
#define XCD_BAR_WORDS 3456
#define XB_SPIN_CAP (1u << 18)

__device__ __forceinline__ unsigned xb_ld(unsigned* p)              { return __hip_atomic_load(p, __ATOMIC_RELAXED, __HIP_MEMORY_SCOPE_AGENT); }
__device__ __forceinline__ unsigned xb_add(unsigned* p, unsigned v) { return __hip_atomic_fetch_add(p, v, __ATOMIC_RELAXED, __HIP_MEMORY_SCOPE_AGENT); }
__device__ __forceinline__ unsigned xb_xcc_id() { return (unsigned)__builtin_amdgcn_s_getreg((3 << 11) | 20) & 0xFu; }
#define XB_SPIN(cond, bar) do { unsigned _sp = 0; while (cond) { __builtin_amdgcn_s_sleep(1); \
    if ((++_sp & 255u) == 0u) { if (xb_ld(&(bar)[XB_TMO])) break; if (_sp > XB_SPIN_CAP) { atomicAdd(&(bar)[XB_TMO], 1u); break; } } } } while (0)

struct XcdBarrier {
    unsigned* bar; unsigned x;
    volatile LAS unsigned* st;
};

__device__ __forceinline__ XcdBarrier xcd_barrier_post(unsigned* bar, volatile LAS unsigned* st) {
    XcdBarrier b; b.bar = bar; b.x = xb_xcc_id(); b.st = st;
    if (threadIdx.x == 0) (void)xb_add(&bar[XB_XCNT(b.x)], 1u);
    return b;
}
__device__ __forceinline__ void xcd_barrier_complete(unsigned* bar, unsigned x, unsigned& nloc, unsigned& nx) {
    const unsigned G = gridDim.x * gridDim.y * gridDim.z;
    unsigned sum, cnt, mine, sp = 0u;
    for (;;) {
        sum = 0u; cnt = 0u; mine = 0u;
#pragma unroll
        for (unsigned j = 0; j < 16; ++j) { const unsigned c = xb_ld(&bar[XB_XCNT(j)]); sum += c; cnt += (c > 0u) ? 1u : 0u; mine = (j == x) ? c : mine; }
        if (sum == G) break;
        __builtin_amdgcn_s_sleep(1);
        if ((++sp & 255u) == 0u) { if (xb_ld(&bar[XB_TMO])) break; if (sp > XB_SPIN_CAP) { atomicAdd(&bar[XB_TMO], 1u); break; } }
    }
    nloc = mine > 0u ? mine : 1u; nx = cnt > 0u ? cnt : 1u;
}

__device__ __forceinline__ void xcd_barrier(const XcdBarrier& b) {
    asm volatile("s_waitcnt vmcnt(0)" ::: "memory");
    __syncthreads();
    if (threadIdx.x == 0) {
        unsigned* bar = b.bar;
        __builtin_amdgcn_s_waitcnt(0);
        unsigned nloc = b.st[0], nx = b.st[1];
        if (nloc == 0u) { xcd_barrier_complete(bar, b.x, nloc, nx); b.st[0] = nloc; b.st[1] = nx; }
        const unsigned old = xb_add(&bar[XB_XSUB(b.x)], 1u);
        const unsigned gen = old / nloc;
        if (old + 1u == (gen + 1u) * nloc) {
            __builtin_amdgcn_fence(__ATOMIC_RELEASE, "agent");
            asm volatile("s_waitcnt vmcnt(0)" ::: "memory");
            const unsigned og = xb_add(&bar[XB_TOP], 1u);
            const unsigned tg = og / nx;
            if (og + 1u == (tg + 1u) * nx) xb_add(&bar[XB_TOPGEN], 1u);
            else XB_SPIN(xb_ld(&bar[XB_TOPGEN]) == tg, bar);
            __builtin_amdgcn_fence(__ATOMIC_ACQUIRE, "agent");
            xb_add(&bar[XB_XGEN(b.x)], 1u);
            asm volatile("s_waitcnt vmcnt(0)" ::: "memory");
        } else {
            XB_SPIN(xb_ld(&bar[XB_XGEN(b.x)]) == gen, bar);
            __builtin_amdgcn_fence(__ATOMIC_ACQUIRE, "agent");
            asm volatile("s_waitcnt vmcnt(0)" ::: "memory");
        }
    }
    __syncthreads();
}

struct Args { const float* in[19]; float* out; unsigned char* ws; int ph_lo, ph_hi, use_bar, pad; };

struct Frame {
    LAS unsigned char* lds;
    int tid, lane, wave, G, bid;
    const float* const* in;
    float* out; unsigned char* ws;
};
__device__ __forceinline__ const float* xrow_ptr(const float* xp, const float* xs, int row) { return row < SEQ ? xp + (size_t)row * DM : xs + (size_t)(row - SEQ) * DM; }

struct EpiIn {
    static constexpr bool PERM = true, AFTER_DRAIN = false;
    bf16 *Qb, *Kb, *Vb, *Ub, *GVb; const float* rope; const float *qnw, *knw, *gnw; float* out;
    __device__ __forceinline__ void operator()(const pg8::f32x4 (&acc)[2][2][4][2], const pg8::Unit& u, int wr, int wc, int fr, int fq) const {
        const int pn = u.pn;
        int kind, head;
        if (pn < 2) { kind = 0; head = pn * 4 + wc; }
        else if (pn == 2) { kind = (wc < 2) ? 1 : 2; head = wc & 1; }
        else if (pn < 5) { kind = 3; head = (pn - 3) * 4 + wc; }
        else { kind = 4; head = (pn - 5) * 4 + wc; }
        float nw[2][8];
        {
            const float* nwp = (kind == 0) ? qnw : (kind == 1) ? knw : (kind == 4) ? gnw + head * 64 : qnw;
#pragma unroll
            for (int bj = 0; bj < 2; ++bj) { const f32x4 a = *(const f32x4*)(nwp + 32 * bj + 8 * fq), b = *(const f32x4*)(nwp + 32 * bj + 8 * fq + 4);
                nw[bj][0] = a[0]; nw[bj][1] = a[1]; nw[bj][2] = a[2]; nw[bj][3] = a[3]; nw[bj][4] = b[0]; nw[bj][5] = b[1]; nw[bj][6] = b[2]; nw[bj][7] = b[3]; }
        }
#pragma unroll
        for (int ai = 0; ai < 2; ++ai)
#pragma unroll
            for (int m = 0; m < 4; ++m) {
                const int row = u.pm * 256 + ai * 128 + wr * 64 + m * 16 + fr;
                const bool ok = row < MTOK;
                float x[2][8];
#pragma unroll
                for (int bj = 0; bj < 2; ++bj)
#pragma unroll
                    for (int n = 0; n < 2; ++n)
#pragma unroll
                        for (int e = 0; e < 4; ++e) x[bj][4 * n + e] = acc[ai][bj][m][n][e];
                if (kind == 3 || kind == 4) {
#pragma unroll
                    for (int bj = 0; bj < 2; ++bj)
#pragma unroll
                        for (int j = 0; j < 8; j += 2) { const f32x2 g = pg8::gelu_pk((f32x2){x[bj][j], x[bj][j + 1]}); x[bj][j] = g.x; x[bj][j + 1] = g.y; }
                }
                if (kind == 0 || kind == 1 || kind == 4) {
                    float ss = 0.f;
#pragma unroll
                    for (int bj = 0; bj < 2; ++bj)
#pragma unroll
                        for (int j = 0; j < 8; ++j) ss += x[bj][j] * x[bj][j];
                    ss += __shfl_xor(ss, 16); ss += __shfl_xor(ss, 32);
                    const float rinv = rsqrtf(ss * (1.0f / 64.0f) + EPS);
#pragma unroll
                    for (int bj = 0; bj < 2; ++bj)
#pragma unroll
                        for (int j = 0; j < 8; ++j) x[bj][j] = x[bj][j] * rinv * nw[bj][j];
                }
                if (kind == 0 || kind == 1) {
                    const int pos = row < SEQ ? row : SEQ;
                    const float* rp = rope + ((size_t)pos * 32 + 8 * fq) * 2;
                    float cs[16];
#pragma unroll
                    for (int t = 0; t < 4; ++t) { const f32x4 v = ok ? *(const f32x4*)(rp + 4 * t) : (f32x4){1.f, 0.f, 1.f, 0.f}; cs[4 * t] = v[0]; cs[4 * t + 1] = v[1]; cs[4 * t + 2] = v[2]; cs[4 * t + 3] = v[3]; }
#pragma unroll
                    for (int j = 0; j < 8; ++j) { const float c = cs[2 * j], s = cs[2 * j + 1], a = x[0][j], b = x[1][j]; x[0][j] = a * c - b * s; x[1][j] = b * c + a * s; }
                }
                if (ok) {
                    bf16* dst; int ld;
                    if (kind == 0) { dst = Qb; ld = 512; } else if (kind == 1) { dst = Kb; ld = 128; } else if (kind == 2) { dst = Vb; ld = 128; } else if (kind == 3) { dst = Ub; ld = 512; } else { dst = GVb; ld = 512; }
                    bf16* rowp = dst + (size_t)row * ld + head * 64 + 8 * fq;
#pragma unroll
                    for (int bj = 0; bj < 2; ++bj) { u32x4 w; w.x = pk2(x[bj][0], x[bj][1]); w.y = pk2(x[bj][2], x[bj][3]); w.z = pk2(x[bj][4], x[bj][5]); w.w = pk2(x[bj][6], x[bj][7]); *(u32x4*)(rowp + 32 * bj) = w; }
                    float* fo = nullptr;
                    if (kind == 1 || kind == 2) {
                        if (row >= SEQ) fo = out + (kind == 1 ? O_NKS : O_NVS) + ((size_t)(row - SEQ) * 128 + 127) * 128 + head * 64;
                        else if (row >= SEQ - 128) fo = out + (kind == 1 ? O_NKP : O_NVP) + (size_t)(row - (SEQ - 128)) * 128 + head * 64;
                    } else if (kind == 4 && row >= SEQ) fo = out + O_NGV + (size_t)(row - SEQ) * 512 + head * 64;
                    if (fo) {
#pragma unroll
                        for (int bj = 0; bj < 2; ++bj) { *(f32x4*)(fo + 32 * bj + 8 * fq) = (f32x4){x[bj][0], x[bj][1], x[bj][2], x[bj][3]}; *(f32x4*)(fo + 32 * bj + 8 * fq + 4) = (f32x4){x[bj][4], x[bj][5], x[bj][6], x[bj][7]}; }
                    }
                }
            }
    }
};

struct EpiOut {
    static constexpr bool PERM = false, AFTER_DRAIN = false;
    const float *xp, *xs; float* out; bf16* HN; float* rowss;
    __device__ __forceinline__ void operator()(const pg8::f32x4 (&acc)[2][2][4][2], const pg8::Unit& u, int wr, int wc, int fr, int fq) const {
#pragma unroll
        for (int ai = 0; ai < 2; ++ai)
#pragma unroll
            for (int m = 0; m < 4; ++m) {
                const int row = u.pm * 256 + ai * 128 + wr * 64 + m * 16 + fr;
                const bool ok = row < MTOK;
                const float* xr = xrow_ptr(xp, xs, ok ? row : 0);
                float ss = 0.f;
#pragma unroll
                for (int bj = 0; bj < 2; ++bj)
#pragma unroll
                    for (int n = 0; n < 2; ++n) {
                        const int col = u.pn * 256 + bj * 128 + wc * 32 + n * 16 + 4 * fq;
                        f32x4 h = acc[ai][bj][m][n];
                        if (ok) { h = h + *(const f32x4*)(xr + col); *(f32x4*)(out + (size_t)row * DM + col) = h;
                            u32x2 w; w.x = pk2(h[0], h[1]); w.y = pk2(h[2], h[3]); *(u32x2*)(HN + (size_t)row * DM + col) = w; }
                        ss += (h[0] * h[0] + h[1] * h[1]) + (h[2] * h[2] + h[3] * h[3]);
                    }
                ss += __shfl_xor(ss, 16); ss += __shfl_xor(ss, 32);
                if (ok && fq == 0) rowss[(size_t)row * 16 + u.pn * 4 + wc] = ss;
            }
    }
};

struct EpiQ {
    static constexpr bool PERM = true, AFTER_DRAIN = false;
    bf16* QP; const float* rowss;
    __device__ __forceinline__ void operator()(const pg8::f32x4 (&acc)[2][2][4][2], const pg8::Unit& u, int wr, int wc, int fr, int fq) const {
#pragma unroll
        for (int ai = 0; ai < 2; ++ai)
#pragma unroll
            for (int m = 0; m < 4; ++m) {
                const int row = u.pm * 256 + ai * 128 + wr * 64 + m * 16 + fr;
                if (row < MTOK) {
                    float ss = 0.f;
#pragma unroll
                    for (int t = 0; t < 4; ++t) { const f32x4 v = *(const f32x4*)(rowss + (size_t)row * 16 + 4 * t); ss += (v[0] + v[1]) + (v[2] + v[3]); }
                    const float r2 = rsqrtf(ss * (1.0f / 1024.0f) + EPS);
#pragma unroll
                    for (int bj = 0; bj < 2; ++bj) { const f32x4 a = acc[ai][bj][m][0] * r2, b = acc[ai][bj][m][1] * r2;
                        u32x4 w; w.x = pk2(a[0], a[1]); w.y = pk2(a[2], a[3]); w.z = pk2(b[0], b[1]); w.w = pk2(b[2], b[3]);
                        *(u32x4*)(QP + (size_t)row * NQ + u.pn * 256 + bj * 128 + wc * 32 + 8 * fq) = w; }
                }
            }
    }
};

__device__ __forceinline__ void p0_transpose_item(const float* W, const float* fold, int K, int N, bf16* WT, bool perm, LAS float* scr, int item, int lane) {
    const int nblk = N / 32, kb = item / nblk, nb = item % nblk, k0 = 64 * kb, n0 = 32 * nb;
    int l0 = n0;
    if (perm) { const int t = n0 & ~255, loc = n0 & 255, bj = loc >> 7, wc = (loc >> 5) & 3; l0 = t + 64 * wc + 32 * bj; }
#pragma unroll 8
    for (int i = 0; i < 32; ++i) { const int kk = 2 * i + (lane >> 5); scr[kk * 33 + (lane & 31)] = W[(size_t)(k0 + kk) * N + l0 + (lane & 31)] * fold[k0 + kk]; }
    asm volatile("s_waitcnt lgkmcnt(0)" ::: "memory");
    const int c = lane & 7;
#pragma unroll
    for (int j = 0; j < 4; ++j) { const int n = (lane >> 3) + 8 * j; const LAS float* s = scr + (8 * c) * 33 + n;
        u32x4 o; o.x = pk2(s[0 * 33], s[1 * 33]); o.y = pk2(s[2 * 33], s[3 * 33]); o.z = pk2(s[4 * 33], s[5 * 33]); o.w = pk2(s[6 * 33], s[7 * 33]);
        *(u32x4*)(WT + (size_t)(n0 + n) * K + k0 + 8 * c) = o; }
    asm volatile("s_waitcnt lgkmcnt(0)" ::: "memory");
}

__device__ __forceinline__ void p0_prologue(Frame& F) {
    LAS float* scr = (LAS float*)(F.lds + F.wave * 16384);
    const int gw = F.bid * NWAVES + F.wave, NGW = F.G * NWAVES, lane = F.lane;
    const int gt = F.bid * 512 + F.tid, NGT = F.G * 512;
    const float* const* in = F.in;
    unsigned char* ws = F.ws;
    { constexpr int I_IN = 16 * (DIN / 32), I_O = 16 * (DM / 32), I_Q = 16 * (NQ / 32);
      for (int it = gw; it < I_IN + I_O + I_Q; it += NGW) {
          int r = it;
          if (r < I_IN) { p0_transpose_item(in[5], in[4], DM, DIN, (bf16*)(ws + WS_WIN), true, scr, r, lane); continue; } r -= I_IN;
          if (r < I_O) { p0_transpose_item(in[13], in[12], DM, DM, (bf16*)(ws + WS_WO), false, scr, r, lane); continue; } r -= I_O;
          p0_transpose_item(in[15], in[14], DM, NQ, (bf16*)(ws + WS_WQ), false, scr, r, lane);
      } }
    for (int row = gw; row < MP; row += NGW) {
        bf16* o0 = (bf16*)(ws + WS_A0) + (size_t)row * DM;
        if (row < MTOK) {
            const f32x4* xr = (const f32x4*)xrow_ptr(in[0], in[1], row) + lane;
            f32x4 v[4]; float s = 0.f;
#pragma unroll
            for (int j = 0; j < 4; ++j) { v[j] = xr[64 * j]; s += (v[j][0] * v[j][0] + v[j][1] * v[j][1]) + (v[j][2] * v[j][2] + v[j][3] * v[j][3]); }
            const float r1 = rsqrtf(wave_sum(s) * (1.0f / DM) + EPS);
#pragma unroll
            for (int j = 0; j < 4; ++j) { u32x2 w; w.x = pk2(v[j][0] * r1, v[j][1] * r1); w.y = pk2(v[j][2] * r1, v[j][3] * r1); ((u32x2*)o0)[64 * j + lane] = w; }
        } else {
            bf16* o1 = (bf16*)(ws + WS_A1) + (size_t)row * DM;
#pragma unroll
            for (int j = 0; j < 4; ++j) { ((u32x2*)o0)[64 * j + lane] = (u32x2){0u, 0u}; ((u32x2*)o1)[64 * j + lane] = (u32x2){0u, 0u}; }
        }
    }
    for (int row = gw; row < 2 * NEXP; row += NGW) {
        const int e = row & (NEXP - 1);
        const float* src = (row < NEXP ? in[17] : in[18]) + (size_t)e * DM;
        bf16* dst = (bf16*)(ws + (row < NEXP ? WS_EU : WS_EV));
        f32x4 v[4];
#pragma unroll
        for (int j = 0; j < 4; ++j) v[j] = ((const f32x4*)src)[64 * j + lane];
#pragma unroll
        for (int j = 0; j < 4; ++j) { u32x2 w; w.x = pk2(v[j][0], v[j][1]); w.y = pk2(v[j][2], v[j][3]);
            *(u32x2*)(dst + ((size_t)(2 * j + (lane >> 5)) * NEXP + e) * 128 + 4 * (lane & 31)) = w; }
    }
    for (int i = gt; i < 262144 / 4; i += NGT) { const f32x4 v = ((const f32x4*)in[16])[i]; u32x2 w; w.x = pk2(v[0], v[1]); w.y = pk2(v[2], v[3]); ((u32x2*)(ws + WS_SK))[i] = w; }
    for (int i = gt; i < 131072 / 4; i += NGT) { f32x4 v = ((const f32x4*)in[10])[i]; const int e0 = 4 * i, t = (e0 >> 7) & 127, s0 = e0 & 127;
        if (s0 + 0 > t) v[0] = 0.f; if (s0 + 1 > t) v[1] = 0.f; if (s0 + 2 > t) v[2] = 0.f; if (s0 + 3 > t) v[3] = 0.f;
        u32x2 w; w.x = pk2(v[0], v[1]); w.y = pk2(v[2], v[3]); ((u32x2*)(ws + WS_WSB))[i] = w; }
    for (int i = gt; i < 16385 * 32; i += NGT) { const int pos = i >> 5, fi = i & 31;
        const float inv = (float)exp2(-(double)fi * (13.287712379549449 / 32.0));
        const float ang = (float)pos * inv;
        double s, c; sincos((double)ang, &s, &c);
        ((f32x2*)(ws + WS_ROPE))[i] = (f32x2){(float)c, (float)s}; }
    for (int i = gt; i < 2 * NSMP * (127 * 128 / 4); i += NGT) { const int kv = i / (NSMP * 4064), r = i % (NSMP * 4064), b = r / 4064, o = r % 4064;
        const f32x4 v = ((const f32x4*)((kv ? in[3] : in[2]) + (size_t)b * 16384 + 128))[o];
        ((f32x4*)(F.out + (kv ? O_NVS : O_NKS) + (size_t)b * 16384))[o] = v; }
}

constexpr int VS_STRIDE = 272, GS_STRIDE = 1040, RED_OFF = 143360;

__device__ __forceinline__ void store_norm_tile(const f32x16 (&O)[2], float scale, bf16* base  , int h) {
#pragma unroll
    for (int dt = 0; dt < 2; ++dt)
#pragma unroll
        for (int g = 0; g < 4; ++g) { u32x2 w; w.x = pk2(O[dt][4 * g] * scale, O[dt][4 * g + 1] * scale); w.y = pk2(O[dt][4 * g + 2] * scale, O[dt][4 * g + 3] * scale);
            *(u32x2*)(base + 32 * dt + 8 * g + 4 * h) = w; }
}

__device__ __forceinline__ void attn_unit(Frame& F, int tq) {
    const int t0 = 32 * tq, w = F.wave, lane = F.lane, r = lane & 31, h = lane >> 5, kvh = w >> 2;
    const bf16* Qb = (const bf16*)(F.ws + WS_QB); const bf16* Kb = (const bf16*)(F.ws + WS_KB); const bf16* Vb = (const bf16*)(F.ws + WS_VB);
    LAS unsigned char* vs = F.lds; LAS float* red = (LAS float*)(F.lds + RED_OFF);
    for (int ci = F.tid; ci < 160 * 16; ci += 512) { const int ks = ci >> 4, c16 = ci & 15, pos = t0 - 128 + ks;
        u32x4 v = (u32x4){0u, 0u, 0u, 0u}; if (pos >= 0) v = *(const u32x4*)(Vb + (size_t)pos * 128 + c16 * 8);
        *(LAS u32x4*)(vs + ks * VS_STRIDE + c16 * 16) = v; }
    bf16x8 qf[4];
#pragma unroll
    for (int ks = 0; ks < 4; ++ks) qf[ks] = *(const bf16x8*)(Qb + (size_t)(t0 + r) * 512 + w * 64 + 16 * ks + 8 * h);
    f32x16 S[5];
#pragma unroll
    for (int kt = 0; kt < 5; ++kt) {
#pragma unroll
        for (int i = 0; i < 16; ++i) S[kt][i] = 0.f;
        int kp = t0 - 128 + 32 * kt + r; kp = kp < 0 ? 0 : kp;
#pragma unroll
        for (int ks = 0; ks < 4; ++ks) { const bf16x8 kf = *(const bf16x8*)(Kb + (size_t)kp * 128 + kvh * 64 + 16 * ks + 8 * h); S[kt] = MFMA32(kf, qf[ks], S[kt]); }
    }
    const float sink = F.in[8][w];
    float mx = sink;
    const int pq = t0 + r;
#pragma unroll
    for (int kt = 0; kt < 5; ++kt)
#pragma unroll
        for (int i = 0; i < 16; ++i) { const int pk = t0 - 128 + 32 * kt + crow(i, h); const bool valid = (pk >= 0) && (pk <= pq) && (pk >= pq - 127);
            const float s = valid ? S[kt][i] * 0.125f : -1e30f; S[kt][i] = s; mx = fmaxf(mx, s); }
    mx = fmaxf(mx, __shfl_xor(mx, 32));
    float sum = 0.f;
#pragma unroll
    for (int kt = 0; kt < 5; ++kt)
#pragma unroll
        for (int i = 0; i < 16; ++i) { const float p = __expf(S[kt][i] - mx); S[kt][i] = p; sum += p; }
    sum += __shfl_xor(sum, 32); sum += __expf(sink - mx);
    const float inv = 1.0f / sum;
    __syncthreads();
    f32x16 O[2];
#pragma unroll
    for (int i = 0; i < 16; ++i) { O[0][i] = 0.f; O[1][i] = 0.f; }
    const int q = (lane & 15) >> 2, p4 = lane & 3, blk = (lane >> 4) & 1;
#pragma unroll
    for (int kt = 0; kt < 5; ++kt)
#pragma unroll
        for (int s = 0; s < 2; ++s) {
            u32x4 pw; pw.x = pk2(S[kt][8 * s], S[kt][8 * s + 1]); pw.y = pk2(S[kt][8 * s + 2], S[kt][8 * s + 3]); pw.z = pk2(S[kt][8 * s + 4], S[kt][8 * s + 5]); pw.w = pk2(S[kt][8 * s + 6], S[kt][8 * s + 7]);
            const bf16x8 pb = __builtin_bit_cast(bf16x8, pw);
#pragma unroll
            for (int dt = 0; dt < 2; ++dt) {
                LAS unsigned char* a0 = vs + (32 * kt + 16 * s + 4 * h + q) * VS_STRIDE + (kvh * 64 + 32 * dt + 16 * blk + 4 * p4) * 2;
                const s16x4 lo = vtr(a0), hi = vtr(a0 + 8 * VS_STRIDE);
                const bf16x8 va = __builtin_shufflevector(lo, hi, 0, 1, 2, 3, 4, 5, 6, 7);
                O[dt] = MFMA32(va, pb, O[dt]);
            }
        }
    float ss = 0.f;
#pragma unroll
    for (int dt = 0; dt < 2; ++dt)
#pragma unroll
        for (int i = 0; i < 16; ++i) { O[dt][i] *= inv; ss += O[dt][i] * O[dt][i]; }
    ss += __shfl_xor(ss, 32);
    if (h == 0) red[w * 32 + r] = ss;
    __syncthreads();
    float tot = 0.f;
#pragma unroll
    for (int ww = 0; ww < 8; ++ww) tot += red[ww * 32 + r];
    const float rn = rsqrtf(tot * (1.0f / 512.0f) + EPS);
    store_norm_tile(O, rn, (bf16*)(F.ws + WS_A1) + (size_t)(t0 + r) * DM + w * 64, h);
    __syncthreads();
}

__device__ __forceinline__ void gate_unit(Frame& F, int tg) {
    const int chunk = tg >> 2, j = tg & 3, tl0 = 32 * j, g0 = 128 * chunk + tl0, nrows = tl0 + 32;
    const int w = F.wave, lane = F.lane, r = lane & 31, h = lane >> 5;
    const bf16* GVb = (const bf16*)(F.ws + WS_GVB); const bf16* Ub = (const bf16*)(F.ws + WS_UB); const bf16* WsB = (const bf16*)(F.ws + WS_WSB);
    LAS unsigned char* gs = F.lds; LAS float* red = (LAS float*)(F.lds + RED_OFF);
    for (int ci = F.tid; ci < nrows * 64; ci += 512) { const int row = ci >> 6, c16 = ci & 63;
        *(LAS u32x4*)(gs + row * GS_STRIDE + c16 * 16) = *(const u32x4*)(GVb + (size_t)(128 * chunk + row) * 512 + c16 * 8); }
    __syncthreads();
    f32x16 Y[2];
#pragma unroll
    for (int i = 0; i < 16; ++i) { Y[0][i] = 0.f; Y[1][i] = 0.f; }
    const int q = (lane & 15) >> 2, p4 = lane & 3, blk = (lane >> 4) & 1;
    const int nks = nrows >> 4;
    for (int ks = 0; ks < nks; ++ks) {
        const bf16x8 wf = *(const bf16x8*)(WsB + (size_t)(w * 128 + tl0 + r) * 128 + 16 * ks + 8 * h);
#pragma unroll
        for (int dt = 0; dt < 2; ++dt) {
            LAS unsigned char* a0 = gs + (16 * ks + 8 * h + q) * GS_STRIDE + (w * 64 + 32 * dt + 16 * blk + 4 * p4) * 2;
            const s16x4 lo = vtr(a0), hi = vtr(a0 + 4 * GS_STRIDE);
            const bf16x8 ga = __builtin_shufflevector(lo, hi, 0, 1, 2, 3, 4, 5, 6, 7);
            Y[dt] = MFMA32(ga, wf, Y[dt]);
        }
    }
    const float bias = F.in[11][w * 128 + tl0 + r];
    float ss = 0.f;
#pragma unroll
    for (int dt = 0; dt < 2; ++dt)
#pragma unroll
        for (int g = 0; g < 4; ++g) { const u16x4 uu = *(const u16x4*)(Ub + (size_t)(g0 + r) * 512 + w * 64 + 32 * dt + 8 * g + 4 * h);
#pragma unroll
            for (int e = 0; e < 4; ++e) { const float v = bf2f(uu[e]) * (Y[dt][4 * g + e] + bias); Y[dt][4 * g + e] = v; ss += v * v; } }
    ss += __shfl_xor(ss, 32);
    if (h == 0) red[w * 32 + r] = ss;
    __syncthreads();
    float tot = 0.f;
#pragma unroll
    for (int ww = 0; ww < 8; ++ww) tot += red[ww * 32 + r];
    const float rn = rsqrtf(tot * (1.0f / 512.0f) + EPS);
    store_norm_tile(Y, rn, (bf16*)(F.ws + WS_A1) + (size_t)(g0 + r) * DM + 512 + w * 64, h);
    __syncthreads();
}

__device__ __forceinline__ void sample_unit(Frame& F, int b) {
    const int row = SEQ + b, w = F.wave, lane = F.lane, kvh = w >> 2;
    const bf16* Qb = (const bf16*)(F.ws + WS_QB); const bf16* Ub = (const bf16*)(F.ws + WS_UB);
    LAS float* qs = (LAS float*)F.lds + w * 64; LAS float* ps = (LAS float*)(F.lds + 2048) + w * 128; LAS float* red = (LAS float*)(F.lds + RED_OFF);
    qs[lane] = bf2f(Qb[(size_t)row * 512 + w * 64 + lane]);
    __syncthreads();
    const float* ck = F.in[2]; const float* cv = F.in[3];
    float s[2];
#pragma unroll
    for (int i = 0; i < 2; ++i) { const int sj = 1 + lane + 64 * i;
        const float* kp = sj < 128 ? ck + ((size_t)(b * 128 + sj) * 2 + kvh) * 64 : F.out + O_NKS + ((size_t)(b * 128 + 127) * 2 + kvh) * 64;
        float d = 0.f;
#pragma unroll
        for (int c = 0; c < 16; ++c) { const f32x4 kk = ((const f32x4*)kp)[c]; const f32x4 qq = ((LAS f32x4*)qs)[c]; d += (kk[0] * qq[0] + kk[1] * qq[1]) + (kk[2] * qq[2] + kk[3] * qq[3]); }
        s[i] = d * 0.125f; }
    const float sink = F.in[8][w];
    const float mx = fmaxf(wave_max(fmaxf(s[0], s[1])), sink);
    const float p0 = __expf(s[0] - mx), p1 = __expf(s[1] - mx);
    const float sum = wave_sum(p0 + p1) + __expf(sink - mx);
    ps[lane] = p0; ps[64 + lane] = p1;
    __syncthreads();
    float o = 0.f;
    for (int kk = 0; kk < 128; ++kk) { const int sj = kk + 1;
        const float* vp = sj < 128 ? cv + ((size_t)(b * 128 + sj) * 2 + kvh) * 64 : F.out + O_NVS + ((size_t)(b * 128 + 127) * 2 + kvh) * 64;
        o += ps[kk] * vp[lane]; }
    o /= sum;
    const float uu = bf2f(Ub[(size_t)row * 512 + w * 64 + lane]);
    const float gvv = F.out[O_NGV + (size_t)b * 512 + w * 64 + lane];
    const float gm = uu * (F.in[10][(size_t)w * 16384] * gvv + F.in[11][w * 128]);
    const float ssa = wave_sum(o * o), ssg = wave_sum(gm * gm);
    if (lane == 0) { red[w] = ssa; red[8 + w] = ssg; }
    __syncthreads();
    float ta = 0.f, tg2 = 0.f;
#pragma unroll
    for (int ww = 0; ww < 8; ++ww) { ta += red[ww]; tg2 += red[8 + ww]; }
    bf16* mix = (bf16*)(F.ws + WS_A1) + (size_t)row * DM;
    mix[w * 64 + lane] = (bf16)f2bf(o * rsqrtf(ta * (1.0f / 512.0f) + EPS));
    mix[512 + w * 64 + lane] = (bf16)f2bf(gm * rsqrtf(tg2 * (1.0f / 512.0f) + EPS));
    __syncthreads();
}

__device__ __forceinline__ int f2key(float f) { const int b = __builtin_bit_cast(int, f); return b ^ ((b >> 31) & 0x7fffffff); }
__device__ __forceinline__ float key2f(int k) { return __builtin_bit_cast(float, k ^ ((k >> 31) & 0x7fffffff)); }
__device__ __forceinline__ void ce_desc(int& a, int& b) { const int hi = a > b ? a : b, lo = a > b ? b : a; a = hi; b = lo; }
__device__ __forceinline__ void sort16_desc(int (&a)[16]) {
#pragma unroll
    for (int k = 2; k <= 16; k <<= 1)
#pragma unroll
        for (int j = k >> 1; j > 0; j >>= 1)
#pragma unroll
            for (int i = 0; i < 16; ++i) { const int l = i ^ j; if (l > i) { if ((i & k) == 0) ce_desc(a[i], a[l]); else ce_desc(a[l], a[i]); } }
}
__device__ __forceinline__ void merge16_desc(int (&a)[16], const int (&b)[16]) {
#pragma unroll
    for (int i = 0; i < 16; ++i) a[i] = a[i] > b[15 - i] ? a[i] : b[15 - i];
#pragma unroll
    for (int j = 8; j > 0; j >>= 1)
#pragma unroll
        for (int i = 0; i < 16; ++i) { const int l = i ^ j; if (l > i) ce_desc(a[i], a[l]); }
}

__device__ __forceinline__ void route_list(const unsigned char* qbase  , const unsigned char* kbase  , unsigned voffq, unsigned voffk, int (&out)[16]) {
    f32x16 acc[4];
#pragma unroll
    for (int mt = 0; mt < 4; ++mt)
#pragma unroll
        for (int i = 0; i < 16; ++i) acc[mt][i] = 0.f;
#pragma unroll 2
    for (int ks = 0; ks < 8; ++ks) {
        const bf16x8 bq = *(const bf16x8*)(qbase + ks * 32 + voffq);
#pragma unroll
        for (int mt = 0; mt < 4; ++mt) { const bf16x8 ak = *(const bf16x8*)(kbase + mt * 8192 + ks * 32 + voffk); acc[mt] = MFMA32(ak, bq, acc[mt]); }
    }
    int k1[16];
#pragma unroll
    for (int i = 0; i < 16; ++i) { out[i] = (f2key(acc[0][i]) & ~127) | (crow(i, 0)); k1[i] = (f2key(acc[1][i]) & ~127) | (32 + crow(i, 0)); }
    sort16_desc(out); sort16_desc(k1); merge16_desc(out, k1);
    int k2[16];
#pragma unroll
    for (int i = 0; i < 16; ++i) { k2[i] = (f2key(acc[2][i]) & ~127) | (64 + crow(i, 0)); k1[i] = (f2key(acc[3][i]) & ~127) | (96 + crow(i, 0)); }
    sort16_desc(k2); sort16_desc(k1); merge16_desc(k2, k1); merge16_desc(out, k2);
}

__device__ __forceinline__ void route_task(Frame& F, int tg, int hp) {
    const int lane = F.lane, r = lane & 31, h = lane >> 5, w = F.wave;
    const int token = 32 * tg + r;
    const unsigned char* QPu = F.ws + WS_QP + ((size_t)(32 * tg) * NQ + (2 * hp) * 256) * 2;
    const unsigned char* SKu = F.ws + WS_SK + (size_t)((2 * hp) * 2 * 128) * 128 * 2;
    const unsigned voffq = (unsigned)(r * NQ + 8 * h) * 2u, voffk = (unsigned)(r * 128 + 8 * h) * 2u;
    const int h4 = 4 * h;
    int T[2][16];
#pragma unroll
    for (int p = 0; p < 2; ++p) {
        int La[16], Lb[16];
        route_list(QPu + p * 256, SKu + p * 32768, voffq, voffk, La);
        __builtin_amdgcn_sched_barrier(0);
        route_list(QPu + 512 + p * 256, SKu + 65536 + p * 32768, voffq, voffk, Lb);
        __builtin_amdgcn_sched_barrier(0);
        int other[16];
#pragma unroll
        for (int i = 0; i < 16; ++i) { const int send = h ? La[i] : Lb[i]; other[i] = __shfl_xor(send, 32) | (4 - h4); T[p][i] = (h ? Lb[i] : La[i]) | h4; }
        merge16_desc(T[p], other);
        __builtin_amdgcn_sched_barrier(0);
    }
    const int head = 2 * hp + h;
    float v1[16], v2[16];
#pragma unroll
    for (int i = 0; i < 16; ++i) { v1[i] = key2f(T[0][i]); v2[i] = key2f(T[1][i]); }
    int c0[16], c1[16], c2[16], c3[16];
    {
        int n = 0;
#pragma unroll
        for (int i = 0; i < 16; ++i)
#pragma unroll
            for (int j = 0; j < 16; ++j) if ((i + 1) * (j + 1) <= 16) {
                const int key = (f2key(v1[i] + v2[j]) & ~255) | (i * 16 + j);
                if (n < 16) c0[n] = key; else if (n < 32) c1[n - 16] = key; else if (n < 48) c2[n - 32] = key; else c3[n - 48] = key;
                ++n;
            }
#pragma unroll
        for (int t = 2; t < 16; ++t) c3[t] = (int)0x80000000;
    }
    sort16_desc(c0); sort16_desc(c1); sort16_desc(c2); sort16_desc(c3);
    merge16_desc(c0, c1); merge16_desc(c2, c3); merge16_desc(c0, c2);
    LAS unsigned* ib = (LAS unsigned*)(F.lds + w * 2048 + lane * 32);
#pragma unroll
    for (int p = 0; p < 2; ++p)
#pragma unroll
        for (int d = 0; d < 4; ++d) ib[p * 4 + d] = (unsigned)(T[p][4 * d] & 127) | ((unsigned)(T[p][4 * d + 1] & 127) << 8) | ((unsigned)(T[p][4 * d + 2] & 127) << 16) | ((unsigned)(T[p][4 * d + 3] & 127) << 24);
    float best[16]; int ex[16];
    LAS unsigned char* ibb = (LAS unsigned char*)ib;
#pragma unroll
    for (int k = 0; k < 16; ++k) { best[k] = key2f(c0[k]); const int tag = c0[k] & 255; ex[k] = (int)ibb[tag >> 4] * 128 + (int)ibb[16 + (tag & 15)]; }
    float den = 0.f;
#pragma unroll
    for (int k = 0; k < 16; ++k) { best[k] = __expf(best[k] - key2f(c0[0])); den += best[k]; }
    const float rd = 1.0f / den;
    if (token < MTOK) {
        u32x4* di = (u32x4*)(F.ws + WS_RID + ((size_t)token * 128 + head * 16) * 2);
        di[0] = (u32x4){(unsigned)ex[0] | ((unsigned)ex[1] << 16), (unsigned)ex[2] | ((unsigned)ex[3] << 16), (unsigned)ex[4] | ((unsigned)ex[5] << 16), (unsigned)ex[6] | ((unsigned)ex[7] << 16)};
        di[1] = (u32x4){(unsigned)ex[8] | ((unsigned)ex[9] << 16), (unsigned)ex[10] | ((unsigned)ex[11] << 16), (unsigned)ex[12] | ((unsigned)ex[13] << 16), (unsigned)ex[14] | ((unsigned)ex[15] << 16)};
        f32x4* dg = (f32x4*)(F.ws + WS_RG + ((size_t)token * 128 + head * 16) * 4);
#pragma unroll
        for (int k = 0; k < 16; k += 4) dg[k >> 2] = (f32x4){best[k] * rd, best[k + 1] * rd, best[k + 2] * rd, best[k + 3] * rd};
    }
}

typedef __bf16 bf16x2v __attribute__((ext_vector_type(2)));
__device__ __forceinline__ float dot2bf(unsigned a, unsigned b, float acc) { return __builtin_amdgcn_fdot2_f32_bf16(__builtin_bit_cast(bf16x2v, a), __builtin_bit_cast(bf16x2v, b), acc, false); }
template <int CTRL> __device__ __forceinline__ float dpp_f(float v) { return __builtin_bit_cast(float, __builtin_amdgcn_update_dpp(0, __builtin_bit_cast(int, v), CTRL, 0xf, 0xf, false)); }
__device__ __forceinline__ float rowsum16(float v) {
    v += dpp_f<0x128>(v);
    v += dpp_f<0x141>(v);
    v += dpp_f<0x4E>(v);
    v += dpp_f<0xB1>(v);
    return v;
}
__device__ __forceinline__ void upass_token(Frame& F, int t, int x) {
    const int lane = F.lane, g = lane >> 4, c = lane & 15;
    const float* hp = F.out + (size_t)t * DM + 128 * x + 8 * c;
    const float* nf = F.in[14] + 128 * x + 8 * c;
    const float* rs = (const float*)(F.ws + WS_ROWSS) + (size_t)t * 16;
    float ss = 0.f;
#pragma unroll
    for (int q = 0; q < 4; ++q) { const f32x4 v = *(const f32x4*)(rs + 4 * q); ss += (v[0] + v[1]) + (v[2] + v[3]); }
    const float r2 = rsqrtf(ss * (1.0f / DM) + EPS);
    const f32x4 h0 = *(const f32x4*)hp, h1 = *(const f32x4*)(hp + 4), n0 = *(const f32x4*)nf, n1 = *(const f32x4*)(nf + 4);
    unsigned xs[4];
    xs[0] = pk2(h0[0] * r2 * n0[0], h0[1] * r2 * n0[1]); xs[1] = pk2(h0[2] * r2 * n0[2], h0[3] * r2 * n0[3]);
    xs[2] = pk2(h1[0] * r2 * n1[0], h1[1] * r2 * n1[1]); xs[3] = pk2(h1[2] * r2 * n1[2], h1[3] * r2 * n1[3]);
    const unsigned short* idp = (const unsigned short*)(F.ws + WS_RID) + (size_t)t * 128 + 32 * g + c;
    const int id_lo = idp[0], id_hi = idp[16];
    const unsigned char* slab = F.ws + WS_EU + (size_t)x * NEXP * 256 + 16 * c;
    float res_lo = 0.f, res_hi = 0.f;
#pragma unroll
    for (int i = 0; i < 32; ++i) {
        const int e = __shfl(i < 16 ? id_lo : id_hi, (lane & 48) + (i & 15));
        const u32x4 row = *(const u32x4*)(slab + (size_t)e * 256);
        float d = dot2bf(row[0], xs[0], 0.f); d = dot2bf(row[1], xs[1], d); d = dot2bf(row[2], xs[2], d); d = dot2bf(row[3], xs[3], d);
        d = rowsum16(d);
        if (i < 16) res_lo = (c == (i & 15)) ? d : res_lo; else res_hi = (c == (i & 15)) ? d : res_hi;
    }
    float* pp = (float*)(F.ws + WS_PART) + ((size_t)x * MTOK + t) * 128 + 32 * g + c;
    pp[0] = res_lo; pp[16] = res_hi;
}
__device__ __forceinline__ void vpass_token(Frame& F, int t, int x) {
    const int lane = F.lane, g = lane >> 4, c = lane & 15;
    const unsigned short* idp = (const unsigned short*)(F.ws + WS_RID) + (size_t)t * 128 + 32 * g + c;
    const int id_lo = idp[0], id_hi = idp[16];
    const float* wp = (const float*)(F.ws + WS_RW) + (size_t)t * 128 + 32 * g + c;
    const float w_lo = wp[0], w_hi = wp[16];
    const unsigned char* slab = F.ws + WS_EV + (size_t)x * NEXP * 256 + 16 * c;
    float acc[8];
#pragma unroll
    for (int j = 0; j < 8; ++j) acc[j] = 0.f;
#pragma unroll
    for (int i = 0; i < 32; ++i) {
        const int src = (lane & 48) + (i & 15);
        const int e = __shfl(i < 16 ? id_lo : id_hi, src);
        const float wv = __shfl(i < 16 ? w_lo : w_hi, src);
        const u32x4 row = *(const u32x4*)(slab + (size_t)e * 256);
#pragma unroll
        for (int k = 0; k < 4; ++k) { acc[2 * k] += wv * bflo(row[k]); acc[2 * k + 1] += wv * bfhi(row[k]); }
    }
#pragma unroll
    for (int j = 0; j < 8; ++j) { acc[j] += __shfl_xor(acc[j], 16); acc[j] += __shfl_xor(acc[j], 32); }
    if (g == 0) {
        float* hp = F.out + (size_t)t * DM + 128 * x + 8 * c;
        const f32x4 h0 = *(const f32x4*)hp, h1 = *(const f32x4*)(hp + 4);
        *(f32x4*)hp = (f32x4){h0[0] + acc[0], h0[1] + acc[1], h0[2] + acc[2], h0[3] + acc[3]};
        *(f32x4*)(hp + 4) = (f32x4){h1[0] + acc[4], h1[1] + acc[5], h1[2] + acc[6], h1[3] + acc[7]};
    }
}

namespace cg = cooperative_groups;
constexpr int NPHASE = 9;
#ifndef DUPMASK
#define DUPMASK 0
#endif
#ifndef SKIPMASK
#define SKIPMASK 0
#endif
#ifndef MK_BAR_KIND
#define MK_BAR_KIND 2
#endif

__global__ void __launch_bounds__(NWAVES * 64, 2) mk_fwd(Args args) {
    extern __shared__ __attribute__((aligned(16))) unsigned char lds_raw[];
    Frame F;
    F.lds = (LAS unsigned char*)lds_raw;
    F.tid = threadIdx.x; F.lane = F.tid & 63; F.wave = __builtin_amdgcn_readfirstlane(F.tid >> 6);
    F.G = gridDim.x; F.bid = blockIdx.x;
    F.in = args.in; F.out = args.out; F.ws = args.ws;
    volatile LAS unsigned* MISC = (volatile LAS unsigned*)(F.lds + MISC_OFF);
    for (int u = F.tid; u < (LDS_BYTES - MISC_OFF) / 4; u += NWAVES * 64) ((LAS unsigned*)(F.lds + MISC_OFF))[u] = 0u;
    __syncthreads();
    XcdBarrier bar; bar.bar = (unsigned*)(F.ws + WS_CTL) + CW_BAR; bar.x = 0; bar.st = nullptr;
    if (args.use_bar == 2) bar = xcd_barrier_post((unsigned*)(F.ws + WS_CTL) + CW_BAR, MISC + 8);
    const int lo = args.ph_lo, hi = args.ph_hi;
#define IN(k) (lo <= (k) && (k) < hi)
#define SEAM(k) do { if (IN(k) && IN((k) + 1)) { if (args.use_bar == 2) xcd_barrier(bar); else cg::this_grid().sync(); } } while (0)

    if (IN(0) && !(SKIPMASK & 1)) for (int rep_ = 0; rep_ < (((DUPMASK >> 0) & 1) ? 2 : 1); ++rep_) { p0_prologue(F); }
    SEAM(0);
    if (IN(1) && !(SKIPMASK & 2)) for (int rep_ = 0; rep_ < (((DUPMASK >> 1) & 1) ? 2 : 1); ++rep_) {
        pg8::Gemm g{(const pg8::bf16_t*)(F.ws + WS_A0), (const pg8::bf16_t*)(F.ws + WS_WIN), MP, DIN, DM}; pg8::StaticOrder S; S.init(MP, DIN, F.G, F.bid);
        EpiIn E{(bf16*)(F.ws + WS_QB), (bf16*)(F.ws + WS_KB), (bf16*)(F.ws + WS_VB), (bf16*)(F.ws + WS_UB), (bf16*)(F.ws + WS_GVB), (const float*)(F.ws + WS_ROPE), F.in[6], F.in[7], F.in[9], F.out};
        pg8::gemm_phase<EpiIn, pg8::StaticOrder, true, true>(F.lds, g, S, E);
    }
    SEAM(1);
    if (IN(2) && !(SKIPMASK & 4)) for (int rep_ = 0; rep_ < (((DUPMASK >> 2) & 1) ? 2 : 1); ++rep_) {
        constexpr int NU = 512 + 512 + NSMP;
        for (int u = F.bid; u < NU; u += F.G) {
            if (u < 512) gate_unit(F, (u & ~3) | (3 - (u & 3)));
            else if (u < 1024) attn_unit(F, u - 512);
            else sample_unit(F, u - 1024);
        }
    }
    SEAM(2);
    if (IN(3) && !(SKIPMASK & 8)) for (int rep_ = 0; rep_ < (((DUPMASK >> 3) & 1) ? 2 : 1); ++rep_) {
        pg8::Gemm g{(const pg8::bf16_t*)(F.ws + WS_A1), (const pg8::bf16_t*)(F.ws + WS_WO), MP, DM, DM}; pg8::StaticOrder S; S.init(MP, DM, F.G, F.bid);
        EpiOut E{F.in[0], F.in[1], F.out, (bf16*)(F.ws + WS_A0), (float*)(F.ws + WS_ROWSS)};
        pg8::gemm_phase<EpiOut, pg8::StaticOrder, true, true>(F.lds, g, S, E);
    }
    SEAM(3);
    if (IN(4) && !(SKIPMASK & 16)) for (int rep_ = 0; rep_ < (((DUPMASK >> 4) & 1) ? 2 : 1); ++rep_) {
        pg8::Gemm g{(const pg8::bf16_t*)(F.ws + WS_A0), (const pg8::bf16_t*)(F.ws + WS_WQ), MP, NQ, DM}; pg8::StaticOrder S; S.init(MP, NQ, F.G, F.bid);
        EpiQ E{(bf16*)(F.ws + WS_QP), (const float*)(F.ws + WS_ROWSS)};
        pg8::gemm_phase<EpiQ, pg8::StaticOrder, true, true>(F.lds, g, S, E);
    }
    SEAM(4);
    if (IN(5) && !(SKIPMASK & 32)) for (int rep_ = 0; rep_ < (((DUPMASK >> 5) & 1) ? 2 : 1); ++rep_) {
        const int gw = F.bid * NWAVES + F.wave, NGW = F.G * NWAVES;
        for (int t = gw; t < (MP / 32) * 4; t += NGW) route_task(F, t >> 2, t & 3);
    }
    SEAM(5);
    if (IN(6) && !(SKIPMASK & 64)) for (int rep_ = 0; rep_ < (((DUPMASK >> 6) & 1) ? 2 : 1); ++rep_) {
        const int x = F.bid & 7, nb = (F.G - x + 7) >> 3, gwx = (F.bid >> 3) * NWAVES + F.wave;
        for (int t = gwx; t < MTOK; t += nb * NWAVES) upass_token(F, t, x);
    }
    SEAM(6);
    if (IN(7) && !(SKIPMASK & 128)) for (int rep_ = 0; rep_ < (((DUPMASK >> 7) & 1) ? 2 : 1); ++rep_) {
        const int gt = F.bid * 512 + F.tid, NGT = F.G * 512;
        const float* part = (const float*)(F.ws + WS_PART); const float* rg = (const float*)(F.ws + WS_RG); float* rw = (float*)(F.ws + WS_RW);
        for (int i = gt; i < MTOK * 128; i += NGT) {
            float d = 0.f;
#pragma unroll
            for (int xx = 0; xx < 8; ++xx) d += part[(size_t)xx * MTOK * 128 + i];
            rw[i] = rg[i] * gelu1(d);
        }
    }
    SEAM(7);
    if (IN(8)) {
        const int x = F.bid & 7, nb = (F.G - x + 7) >> 3, gwx = (F.bid >> 3) * NWAVES + F.wave;
        for (int t = gwx; t < MTOK; t += nb * NWAVES) vpass_token(F, t, x);
    }
#undef IN
#undef SEAM
}

#ifndef MK_N_LAUNCHES
#define MK_N_LAUNCHES 1
#endif
extern "C" void kernel_launch(void* const* d_in, const int* in_sizes, int n_in, void* d_out, int out_size, void* d_ws, size_t ws_size, hipStream_t stream) {
    static int grid = 0;
    if (grid == 0) {
        if (n_in != 19 || out_size != (int)O_END || ws_size < WS_END) { fprintf(stderr, "kernel_launch: unexpected shapes (n_in %d out %d ws %zu)\n", n_in, out_size, ws_size); grid = -1; return; }
        int dev = 0, cus = 0, per_cu = 0;
        hipGetDevice(&dev); hipDeviceGetAttribute(&cus, hipDeviceAttributeMultiprocessorCount, dev);
        if (hipFuncSetAttribute((const void*)mk_fwd, hipFuncAttributeMaxDynamicSharedMemorySize, LDS_BYTES) != hipSuccess) { fprintf(stderr, "kernel_launch: hipFuncSetAttribute failed\n"); grid = -1; return; }
        if (hipOccupancyMaxActiveBlocksPerMultiprocessor(&per_cu, (const void*)mk_fwd, NWAVES * 64, LDS_BYTES) != hipSuccess || per_cu < 1) { fprintf(stderr, "kernel_launch: occupancy query says %d\n", per_cu); }
        (void)hipGetLastError();
        grid = cus;
    }
    if (grid < 0) return;
    hipMemsetAsync((char*)d_ws + WS_CTL, 0, CTL_ZERO_BYTES, stream);
    Args a{};
    for (int i = 0; i < 19; ++i) a.in[i] = (const float*)d_in[i];
    a.out = (float*)d_out; a.ws = (unsigned char*)d_ws;
#if MK_N_LAUNCHES == 1
    a.ph_lo = 0; a.ph_hi = NPHASE; a.use_bar = MK_BAR_KIND;
    void* kargs[] = {&a};
    hipError_t e = hipLaunchCooperativeKernel((const void*)mk_fwd, dim3(grid), dim3(NWAVES * 64), kargs, LDS_BYTES, stream);
    if (e != hipSuccess) fprintf(stderr, "cooperative launch failed: %s (grid %d)\n", hipGetErrorString(e), grid);
#else
    for (int li = 0; li < NPHASE; ++li) {
        a.ph_lo = li; a.ph_hi = li + 1; a.use_bar = 0;
        hipLaunchKernelGGL(mk_fwd, dim3(grid), dim3(NWAVES * 64), LDS_BYTES, stream, a);
    }
#endif
}
```

```cpp
#include <hip/hip_runtime.h>
#include <hip/hip_cooperative_groups.h>
#include <cstdio>
#include <cstdint>
namespace pg8 {
#define PG8_LAS __attribute__((address_space(3)))
typedef unsigned short bf16_t;
typedef short bf16x8 __attribute__((ext_vector_type(8)));
typedef float f32x4 __attribute__((ext_vector_type(4)));
typedef unsigned u32x4 __attribute__((ext_vector_type(4)));
constexpr int BM = 256, BK = 64, HALF = 128, HTB = HALF * BK * 2  , STAGE_BYTES = 8 * HTB, NXCD = 8, WGM = 8;

__host__ __device__ __forceinline__ int lds_byte(int r, int c) { const int st = (r >> 4) * 2 + (c >> 5), rr = r & 15, cc = c & 31, ob = rr * 64 + cc * 2; return st * 1024 + (ob ^ (((ob >> 9) & 1) << 5)); }
__host__ __device__ __forceinline__ void stage_rc(int b, int& R, int& C) { const int st = b / 1024, sb = b % 1024, swz = sb ^ (((sb >> 9) & 1) << 5); R = (st >> 1) * 16 + swz / 64; C = (st & 1) * 32 + (swz % 64) / 2; }
__host__ __device__ __forceinline__ int perm32(int rho) { const int n = rho >> 4, i = rho & 15; return 8 * (i >> 2) + 4 * n + (i & 3); }

struct Unit { int pm, pn; };
struct Gemm { const bf16_t* A; const bf16_t* Bt; int M, N, K; };

struct StaticOrder {
    int nM, nN, nwg, G, c;
    __host__ __device__ void init(int M, int N, int G_, int c_) { nM = M / BM; nN = N / BM; nwg = nM * nN; G = G_; c = c_; }
    __host__ __device__ bool next(int i, Unit& u) const {
        const long L = (long)i * G + c; if (L >= nwg) return false;
        int wgid = (int)L; { const int q = nwg / NXCD, r = nwg % NXCD, xcd = wgid % NXCD, off = wgid / NXCD; wgid = (xcd < r ? xcd * (q + 1) : r * (q + 1) + (xcd - r) * q) + off; }
        const int nig = WGM * nN, gid = wgid / nig, fm = gid * WGM, gsz = (nM - fm) < WGM ? (nM - fm) : WGM;
        u.pm = fm + ((wgid % nig) % gsz); u.pn = (wgid % nig) / gsz; return true;
    }
    __device__ __forceinline__ void a_ready(const Unit&) const {}
    __device__ __forceinline__ void done(const Unit&) const {}
};

__device__ __forceinline__ unsigned cvt_pk_bf16(float lo, float hi) { unsigned r; asm volatile("v_cvt_pk_bf16_f32 %0, %1, %2" : "=v"(r) : "v"(lo), "v"(hi)); return r; }
typedef float f32x2 __attribute__((ext_vector_type(2)));
__device__ __forceinline__ f32x2 gelu_pk(f32x2 v) {
    const f32x2 av = __builtin_elementwise_abs(v), d = av * 0.2316418882f + 1.0f;
    f32x2 t; t.x = __builtin_amdgcn_rcpf(d.x); t.y = __builtin_amdgcn_rcpf(d.y);
    f32x2 q = t * 0.5307027145f + (-0.7265760135f); q = q * t + 0.7107068705f; q = q * t + (-0.142248368f); q = q * t + 0.127414796f; q = q * t;
    const f32x2 s = (v * v) * (-0.72134752044f);
    f32x2 e; e.x = __builtin_amdgcn_exp2f(s.x); e.y = __builtin_amdgcn_exp2f(s.y);
    const f32x2 m = v * (q * e), r = v - m;
    f32x2 o; o.x = v.x < 0.f ? m.x : r.x; o.y = v.y < 0.f ? m.y : r.y; return o;
}
template <class Epi, class Sched, bool ALIGN_EPI = false, bool SP2 = false>
__device__ __forceinline__ void gemm_phase(PG8_LAS unsigned char* lds, const Gemm g, const Sched& S, const Epi& E) {
    const int tid = threadIdx.x, wid = __builtin_amdgcn_readfirstlane(tid >> 6), lane = tid & 63, wr = wid >> 2, wc = wid & 3, fr = lane & 15, fq = lane >> 4;
    const int K = g.K, nt = K / BK;
    unsigned voffA[2], voffB[2];
#pragma unroll
    for (int i = 0; i < 2; ++i) { int R, C; stage_rc(tid * 16 + i * 8192, R, C); const int Rb = Epi::PERM ? ((R & ~31) + perm32(R & 31)) : R;
        voffA[i] = (unsigned)(R * K + C) * 2u; voffB[i] = (unsigned)(Rb * K + C) * 2u; }
    const size_t kstep = (size_t)(BK * 2);
    const size_t hstep = (size_t)HALF * K * 2;
    const size_t tstep = 2 * hstep;
    const unsigned ldsw = (unsigned)wid * 1024u;
    const int aoff = lds_byte(wr * 64 + fr, fq * 8), boff = lds_byte(wc * 32 + fr, fq * 8);
#define PG8_SA(b, h) (((b) * 2 + (h)) * HTB)
#define PG8_SB(b, h) ((4 + (b) * 2 + (h)) * HTB)
#define PG8_STAGE(bufoff, gbase, voff) do { _Pragma("unroll") for (int _i = 0; _i < 2; ++_i) \
        __builtin_amdgcn_global_load_lds((const unsigned*)((const char*)(gbase) + (voff)[_i]), (PG8_LAS unsigned*)(lds + (bufoff) + ldsw + _i * 8192), 16, 0, 0); } while (0)
#define PG8_LDA(dst, b, h) do { _Pragma("unroll") for (int m = 0; m < 4; ++m) _Pragma("unroll") for (int k = 0; k < 2; ++k) dst[m][k] = *(const PG8_LAS bf16x8*)(lds + PG8_SA(b, h) + aoff + m * 2048 + k * 1024); } while (0)
#define PG8_LDB(dst, b, h) do { _Pragma("unroll") for (int n = 0; n < 2; ++n) _Pragma("unroll") for (int k = 0; k < 2; ++k) dst[n][k] = *(const PG8_LAS bf16x8*)(lds + PG8_SB(b, h) + boff + n * 2048 + k * 1024); } while (0)
#define PG8_MMA(ai, bj, At, Bt) do { __builtin_amdgcn_s_setprio(1); _Pragma("unroll") for (int m = 0; m < 4; ++m) _Pragma("unroll") for (int n = 0; n < 2; ++n) _Pragma("unroll") for (int k = 0; k < 2; ++k) \
        acc[ai][bj][m][n] = __builtin_amdgcn_mfma_f32_16x16x32_bf16(Bt[n][k], At[m][k], acc[ai][bj][m][n], 0, 0, 0); __builtin_amdgcn_s_setprio(0); } while (0)
#define PG8_WAIT_V(n) asm volatile("s_waitcnt vmcnt(" #n ")" ::: "memory")
#define PG8_WAIT_L(n) asm volatile("s_waitcnt lgkmcnt(" #n ")" ::: "memory")
#define PG8_BAR __builtin_amdgcn_s_barrier()
#define PG8_SCHED __builtin_amdgcn_sched_barrier(0)
    Unit cur, nxt; int ui = 0;
    if (!S.next(0, cur)) return;
    f32x4 acc[2][2][4][2];
#pragma unroll
    for (int a = 0; a < 2; ++a)
#pragma unroll
        for (int b = 0; b < 2; ++b)
#pragma unroll
            for (int m = 0; m < 4; ++m)
#pragma unroll
                for (int n = 0; n < 2; ++n) acc[a][b][m][n] = (f32x4){0.f, 0.f, 0.f, 0.f};
    bf16x8 At[4][2], B0[2][2], B1[2][2];
    const char* cA = (const char*)g.A + (size_t)cur.pm * tstep; const char* cB = (const char*)g.Bt + (size_t)cur.pn * tstep;
    S.a_ready(cur);
    if constexpr (SP2) {
        PG8_STAGE(PG8_SB(0, 0), cB, voffB); PG8_STAGE(PG8_SB(0, 1), cB + hstep, voffB); PG8_STAGE(PG8_SA(0, 0), cA, voffA); PG8_STAGE(PG8_SA(0, 1), cA + hstep, voffA);
        if (wr == 1) PG8_BAR;
        PG8_WAIT_V(2); PG8_BAR;
        PG8_STAGE(PG8_SB(1, 0), cB + kstep, voffB); PG8_STAGE(PG8_SA(1, 0), cA + kstep, voffA); PG8_STAGE(PG8_SB(1, 1), cB + hstep + kstep, voffB);
        PG8_WAIT_V(6); PG8_BAR;
    } else {
        PG8_STAGE(PG8_SB(0, 0), cB, voffB); PG8_STAGE(PG8_SA(0, 0), cA, voffA); PG8_STAGE(PG8_SB(0, 1), cB + hstep, voffB); PG8_STAGE(PG8_SA(0, 1), cA + hstep, voffA);
        if (wr == 1) PG8_BAR;
        PG8_WAIT_V(4); PG8_BAR;
        PG8_STAGE(PG8_SB(1, 0), cB + kstep, voffB); PG8_STAGE(PG8_SA(1, 0), cA + kstep, voffA); PG8_STAGE(PG8_SB(1, 1), cB + hstep + kstep, voffB);
        PG8_WAIT_V(6); PG8_BAR;
    }
    for (;;) {
        const bool has_next = S.next(ui + 1, nxt);
        const char* nA = has_next ? (const char*)g.A + (size_t)nxt.pm * tstep : cA; const char* nB = has_next ? (const char*)g.Bt + (size_t)nxt.pn * tstep : cB;
        for (int t = 0; t < nt; t += 2) {
            const bool last = (t == nt - 2);
            const char* a1 = cA + (size_t)(t + 1) * kstep;
            const char* a2 = last ? nA : cA + (size_t)(t + 2) * kstep; const char* b2 = last ? nB : cB + (size_t)(t + 2) * kstep;
            const char* a3 = a2 + kstep; const char* b3 = b2 + kstep;
            if (last && has_next) S.a_ready(nxt);
            if constexpr (SP2) {
            PG8_LDB(B0, 0, 0); PG8_LDB(B1, 0, 1); PG8_SCHED; PG8_LDA(At, 0, 0); PG8_STAGE(PG8_SA(1, 1), a1 + hstep, voffA);
            PG8_WAIT_V(8); PG8_WAIT_L(0); PG8_BAR; PG8_MMA(0, 0, At, B0); PG8_MMA(0, 1, At, B1); PG8_BAR; PG8_SCHED;
            PG8_LDA(At, 0, 1); PG8_STAGE(PG8_SB(0, 0), b2, voffB); PG8_STAGE(PG8_SB(0, 1), b2 + hstep, voffB); PG8_STAGE(PG8_SA(0, 0), a2, voffA);
            PG8_WAIT_V(8); PG8_WAIT_L(0); PG8_BAR; PG8_MMA(1, 0, At, B0); PG8_MMA(1, 1, At, B1); PG8_BAR; PG8_SCHED;
            PG8_LDB(B0, 1, 0); PG8_LDB(B1, 1, 1); PG8_SCHED; PG8_LDA(At, 1, 0); PG8_STAGE(PG8_SA(0, 1), a2 + hstep, voffA);
            PG8_WAIT_V(8); PG8_WAIT_L(0); PG8_BAR; PG8_MMA(0, 0, At, B0); PG8_MMA(0, 1, At, B1); PG8_BAR; PG8_SCHED;
            PG8_LDA(At, 1, 1); PG8_STAGE(PG8_SB(1, 0), b3, voffB); PG8_STAGE(PG8_SB(1, 1), b3 + hstep, voffB); PG8_STAGE(PG8_SA(1, 0), a3, voffA);
            PG8_WAIT_V(8); PG8_WAIT_L(0); PG8_BAR; PG8_MMA(1, 0, At, B0); PG8_MMA(1, 1, At, B1); PG8_BAR; PG8_SCHED;
            } else {
            PG8_LDB(B0, 0, 0); PG8_SCHED; PG8_LDA(At, 0, 0); PG8_STAGE(PG8_SA(1, 1), a1 + hstep, voffA);
            PG8_WAIT_L(8); PG8_BAR; PG8_WAIT_L(0); PG8_MMA(0, 0, At, B0); PG8_BAR; PG8_SCHED;
            PG8_LDB(B1, 0, 1); PG8_STAGE(PG8_SB(0, 0), b2, voffB);
            PG8_BAR; PG8_WAIT_L(0); PG8_MMA(0, 1, At, B1); PG8_BAR;
            PG8_LDA(At, 0, 1); PG8_STAGE(PG8_SA(0, 0), a2, voffA);
            PG8_BAR; PG8_WAIT_L(0); PG8_MMA(1, 0, At, B0); PG8_BAR; PG8_SCHED;
            PG8_STAGE(PG8_SB(0, 1), b2 + hstep, voffB);
            PG8_WAIT_V(6); PG8_BAR; PG8_MMA(1, 1, At, B1); PG8_BAR;
            PG8_LDB(B0, 1, 0); PG8_SCHED; PG8_LDA(At, 1, 0); PG8_STAGE(PG8_SA(0, 1), a2 + hstep, voffA);
            PG8_WAIT_L(8); PG8_BAR; PG8_WAIT_L(0); PG8_MMA(0, 0, At, B0); PG8_BAR; PG8_SCHED;
            PG8_LDB(B1, 1, 1); PG8_STAGE(PG8_SB(1, 0), b3, voffB);
            PG8_BAR; PG8_WAIT_L(0); PG8_MMA(0, 1, At, B1); PG8_BAR;
            PG8_LDA(At, 1, 1); PG8_STAGE(PG8_SA(1, 0), a3, voffA);
            PG8_BAR; PG8_WAIT_L(0); PG8_MMA(1, 0, At, B0); PG8_BAR; PG8_SCHED;
            PG8_STAGE(PG8_SB(1, 1), b3 + hstep, voffB);
            PG8_WAIT_V(6); PG8_BAR; PG8_MMA(1, 1, At, B1); PG8_BAR;
            }
        }
        if constexpr (ALIGN_EPI) { if (wr == 0) PG8_BAR; }
        if constexpr (!Epi::AFTER_DRAIN) { E(acc, cur, wr, wc, fr, fq); S.done(cur); }
        if (!has_next) break;
#pragma unroll
        for (int a = 0; a < 2; ++a)
#pragma unroll
            for (int b = 0; b < 2; ++b)
#pragma unroll
                for (int m = 0; m < 4; ++m)
#pragma unroll
                    for (int n = 0; n < 2; ++n) acc[a][b][m][n] = (f32x4){0.f, 0.f, 0.f, 0.f};
        cur = nxt; cA = nA; cB = nB; ++ui;
        if constexpr (ALIGN_EPI) { if (wr == 1) PG8_BAR; }
    }
    PG8_WAIT_V(0);
    if constexpr (!ALIGN_EPI) { if (wr == 0) PG8_BAR; }
    PG8_BAR;
    if constexpr (Epi::AFTER_DRAIN) { E.fused(acc, cur, wr, wc, fr, fq, lds, wid, lane); S.done(cur); }
#undef PG8_SA
#undef PG8_SB
#undef PG8_STAGE
#undef PG8_LDA
#undef PG8_LDB
#undef PG8_MMA
#undef PG8_WAIT_V
#undef PG8_WAIT_L
#undef PG8_BAR
#undef PG8_SCHED
}
}
#ifndef VPROBE
#define VPROBE 0
#endif

constexpr int DM = 1024, SEQ = 16384, NSMP = 128, MTOK = SEQ + NSMP  , MP = 16640  ;
constexpr int DIN = 1792, NQ = 2048, NEXP = 16384;
constexpr float EPS = 1e-6f;
constexpr int NWAVES = 8;

#define GAS __attribute__((address_space(1)))
#define LAS __attribute__((address_space(3)))
typedef unsigned short bf16;
typedef unsigned u32x4 __attribute__((ext_vector_type(4)));
typedef unsigned u32x2 __attribute__((ext_vector_type(2)));
typedef float f32x4 __attribute__((ext_vector_type(4)));
typedef float f32x2 __attribute__((ext_vector_type(2)));
typedef float f32x16 __attribute__((ext_vector_type(16)));
typedef short bf16x8 __attribute__((ext_vector_type(8)));
typedef short s16x4 __attribute__((ext_vector_type(4)));
typedef unsigned short u16x4 __attribute__((ext_vector_type(4)));
typedef int i32x2 __attribute__((ext_vector_type(2)));
typedef __bf16 bf16x2_t __attribute__((ext_vector_type(2)));

constexpr size_t MiB = 1u << 20;
constexpr size_t WS_CTL = 0, CTL_ZERO_BYTES = 1 * MiB;
constexpr size_t WS_WIN = 1 * MiB;
constexpr size_t WS_WO = 5 * MiB;
constexpr size_t WS_WQ = 7 * MiB;
constexpr size_t WS_SK = 11 * MiB;
constexpr size_t WS_WSB = 11 * MiB + 512 * 1024;
constexpr size_t WS_ROWSS = 12 * MiB;
constexpr size_t WS_ROPE = 14 * MiB;
constexpr size_t WS_SU = 19 * MiB;
constexpr size_t WS_EU = 20 * MiB;
constexpr size_t WS_EV = 52 * MiB;
constexpr size_t WS_A0 = 84 * MiB;
constexpr size_t WS_A1 = 117 * MiB;
constexpr size_t WS_QB = 150 * MiB;
constexpr size_t WS_KB = 167 * MiB;
constexpr size_t WS_VB = 172 * MiB;
constexpr size_t WS_UB = 177 * MiB;
constexpr size_t WS_GVB = 194 * MiB;
constexpr size_t WS_QP = 150 * MiB;
constexpr size_t WS_PART = 150 * MiB;
constexpr size_t WS_RID = 216 * MiB;
constexpr size_t WS_RG = 221 * MiB;
constexpr size_t WS_RW = 230 * MiB;
constexpr size_t WS_ROUTE = 216 * MiB;
constexpr size_t WS_END = 256 * MiB;
static_assert(WS_A0 + (size_t)MP * DM * 2 <= WS_A1 && WS_A1 + (size_t)MP * DM * 2 <= WS_QB && WS_QP + (size_t)MP * NQ * 2 <= WS_ROUTE && WS_RW + (size_t)MTOK * 128 * 4 <= WS_END && WS_RID + (size_t)MTOK * 128 * 2 <= WS_RG && WS_RG + (size_t)MTOK * 128 * 4 <= WS_RW && WS_PART + (size_t)8 * MTOK * 128 * 4 <= WS_ROUTE, "ws map");
static_assert(WS_GVB + (size_t)MP * 512 * 2 <= WS_ROUTE && WS_ROPE + (size_t)16385 * 64 * 4 <= WS_SU && WS_ROWSS + (size_t)16 * MP * 4 <= WS_ROPE, "ws map 2");

constexpr size_t O_Y = 0, O_NKP = 16908288, O_NVP = 16924672, O_NKS = 16941056, O_NVS = 19038208, O_NGV = 21135360, O_END = 21200896;

constexpr int CW_BAR = 4096;

constexpr int SCR_BYTES = 147456;
constexpr int MISC_OFF = SCR_BYTES;
constexpr int LDS_BYTES = SCR_BYTES + 1024;

__device__ __forceinline__ unsigned f2bf(float f) { unsigned u = __builtin_bit_cast(unsigned, f); return (u + 0x7fffu + ((u >> 16) & 1u)) >> 16; }
__device__ __forceinline__ unsigned pk2(float lo, float hi) { f32x2 v = {lo, hi}; bf16x2_t b = __builtin_convertvector(v, bf16x2_t); return __builtin_bit_cast(unsigned, b); }
__device__ __forceinline__ float bf2f(unsigned short b) { return __builtin_bit_cast(float, (unsigned)b << 16); }
__device__ __forceinline__ float bflo(unsigned w) { return __builtin_bit_cast(float, w << 16); }
__device__ __forceinline__ float bfhi(unsigned w) { return __builtin_bit_cast(float, w & 0xffff0000u); }
__device__ __forceinline__ float wave_sum(float v) {
#pragma unroll
    for (int o = 1; o < 64; o <<= 1) v += __shfl_xor(v, o);
    return v;
}
__device__ __forceinline__ float wave_max(float v) {
#pragma unroll
    for (int o = 1; o < 64; o <<= 1) v = fmaxf(v, __shfl_xor(v, o));
    return v;
}
__device__ __forceinline__ int crow(int reg, int h) { return (reg & 3) + 8 * (reg >> 2) + 4 * h; }
__device__ __forceinline__ float gelu1(float v) { f32x2 r = pg8::gelu_pk((f32x2){v, v}); return r.x; }
#define MFMA32(a, b, c) __builtin_amdgcn_mfma_f32_32x32x16_bf16((a), (b), (c), 0, 0, 0)
typedef short v4i16_t __attribute__((ext_vector_type(4)));
__device__ __forceinline__ s16x4 vtr(LAS unsigned char* p) { return __builtin_bit_cast(s16x4, __builtin_amdgcn_ds_read_tr16_b64_v4i16((LAS v4i16_t*)p)); }

#define XB_TMO      128
#define XB_XCNT(j)  (256  + 64 * (j))
#define XB_XSUB(j)  (1280 + 64 * (j))
#define XB_XGEN(j)  (2304 + 64 * (j))
#define XB_TOP      3328
#define XB_TOPGEN   3392
#define XCD_BAR_WORDS 3456
#define XB_SPIN_CAP (1u << 18)

__device__ __forceinline__ unsigned xb_ld(unsigned* p)              { return __hip_atomic_load(p, __ATOMIC_RELAXED, __HIP_MEMORY_SCOPE_AGENT); }
__device__ __forceinline__ unsigned xb_add(unsigned* p, unsigned v) { return __hip_atomic_fetch_add(p, v, __ATOMIC_RELAXED, __HIP_MEMORY_SCOPE_AGENT); }
__device__ __forceinline__ unsigned xb_xcc_id() { return (unsigned)__builtin_amdgcn_s_getreg((3 << 11) | 20) & 0xFu; }
#define XB_SPIN(cond, bar) do { unsigned _sp = 0; while (cond) { __builtin_amdgcn_s_sleep(1); \
    if ((++_sp & 255u) == 0u) { if (xb_ld(&(bar)[XB_TMO])) break; if (_sp > XB_SPIN_CAP) { atomicAdd(&(bar)[XB_TMO], 1u); break; } } } } while (0)

struct XcdBarrier {
    unsigned* bar; unsigned x;
    volatile LAS unsigned* st;
};

__device__ __forceinline__ XcdBarrier xcd_barrier_post(unsigned* bar, volatile LAS unsigned* st) {
    XcdBarrier b; b.bar = bar; b.x = xb_xcc_id(); b.st = st;
    if (threadIdx.x == 0) (void)xb_add(&bar[XB_XCNT(b.x)], 1u);
    return b;
}
__device__ __forceinline__ void xcd_barrier_complete(unsigned* bar, unsigned x, unsigned& nloc, unsigned& nx) {
    const unsigned G = gridDim.x * gridDim.y * gridDim.z;
    unsigned sum, cnt, mine, sp = 0u;
    for (;;) {
        sum = 0u; cnt = 0u; mine = 0u;
#pragma unroll
        for (unsigned j = 0; j < 16; ++j) { const unsigned c = xb_ld(&bar[XB_XCNT(j)]); sum += c; cnt += (c > 0u) ? 1u : 0u; mine = (j == x) ? c : mine; }
        if (sum == G) break;
        __builtin_amdgcn_s_sleep(1);
        if ((++sp & 255u) == 0u) { if (xb_ld(&bar[XB_TMO])) break; if (sp > XB_SPIN_CAP) { atomicAdd(&bar[XB_TMO], 1u); break; } }
    }
    nloc = mine > 0u ? mine : 1u; nx = cnt > 0u ? cnt : 1u;
}

__device__ __forceinline__ void xcd_barrier(const XcdBarrier& b) {
    asm volatile("s_waitcnt vmcnt(0)" ::: "memory");
    __syncthreads();
    if (threadIdx.x == 0) {
        unsigned* bar = b.bar;
        __builtin_amdgcn_s_waitcnt(0);
        unsigned nloc = b.st[0], nx = b.st[1];
        if (nloc == 0u) { xcd_barrier_complete(bar, b.x, nloc, nx); b.st[0] = nloc; b.st[1] = nx; }
        const unsigned old = xb_add(&bar[XB_XSUB(b.x)], 1u);
        const unsigned gen = old / nloc;
        if (old + 1u == (gen + 1u) * nloc) {
            __builtin_amdgcn_fence(__ATOMIC_RELEASE, "agent");
            asm volatile("s_waitcnt vmcnt(0)" ::: "memory");
            const unsigned og = xb_add(&bar[XB_TOP], 1u);
            const unsigned tg = og / nx;
            if (og + 1u == (tg + 1u) * nx) xb_add(&bar[XB_TOPGEN], 1u);
            else XB_SPIN(xb_ld(&bar[XB_TOPGEN]) == tg, bar);
            __builtin_amdgcn_fence(__ATOMIC_ACQUIRE, "agent");
            xb_add(&bar[XB_XGEN(b.x)], 1u);
            asm volatile("s_waitcnt vmcnt(0)" ::: "memory");
        } else {
            XB_SPIN(xb_ld(&bar[XB_XGEN(b.x)]) == gen, bar);
            __builtin_amdgcn_fence(__ATOMIC_ACQUIRE, "agent");
            asm volatile("s_waitcnt vmcnt(0)" ::: "memory");
        }
    }
    __syncthreads();
}

struct Args { const float* in[19]; float* out; unsigned char* ws; int ph_lo, ph_hi, use_bar, pad; };

struct Frame {
    LAS unsigned char* lds;
    int tid, lane, wave, G, bid;
    const float* const* in;
    float* out; unsigned char* ws;
};
__device__ __forceinline__ const float* xrow_ptr(const float* xp, const float* xs, int row) { return row < SEQ ? xp + (size_t)row * DM : xs + (size_t)(row - SEQ) * DM; }

struct EpiIn {
    static constexpr bool PERM = true, AFTER_DRAIN = false;
    bf16 *Qb, *Kb, *Vb, *Ub, *GVb; const float* rope; const float *qnw, *knw, *gnw; float* out;
    __device__ __forceinline__ void operator()(const pg8::f32x4 (&acc)[2][2][4][2], const pg8::Unit& u, int wr, int wc, int fr, int fq) const {
        const int pn = u.pn;
        int kind, head;
        if (pn < 2) { kind = 0; head = pn * 4 + wc; }
        else if (pn == 2) { kind = (wc < 2) ? 1 : 2; head = wc & 1; }
        else if (pn < 5) { kind = 3; head = (pn - 3) * 4 + wc; }
        else { kind = 4; head = (pn - 5) * 4 + wc; }
        float nw[2][8];
        {
            const float* nwp = (kind == 0) ? qnw : (kind == 1) ? knw : (kind == 4) ? gnw + head * 64 : qnw;
#pragma unroll
            for (int bj = 0; bj < 2; ++bj) { const f32x4 a = *(const f32x4*)(nwp + 32 * bj + 8 * fq), b = *(const f32x4*)(nwp + 32 * bj + 8 * fq + 4);
                nw[bj][0] = a[0]; nw[bj][1] = a[1]; nw[bj][2] = a[2]; nw[bj][3] = a[3]; nw[bj][4] = b[0]; nw[bj][5] = b[1]; nw[bj][6] = b[2]; nw[bj][7] = b[3]; }
        }
#pragma unroll
        for (int ai = 0; ai < 2; ++ai)
#pragma unroll
            for (int m = 0; m < 4; ++m) {
                const int row = u.pm * 256 + ai * 128 + wr * 64 + m * 16 + fr;
                const bool ok = row < MTOK;
                float x[2][8];
#pragma unroll
                for (int bj = 0; bj < 2; ++bj)
#pragma unroll
                    for (int n = 0; n < 2; ++n)
#pragma unroll
                        for (int e = 0; e < 4; ++e) x[bj][4 * n + e] = acc[ai][bj][m][n][e];
                if (kind == 3 || kind == 4) {
#pragma unroll
                    for (int bj = 0; bj < 2; ++bj)
#pragma unroll
                        for (int j = 0; j < 8; j += 2) { const f32x2 g = pg8::gelu_pk((f32x2){x[bj][j], x[bj][j + 1]}); x[bj][j] = g.x; x[bj][j + 1] = g.y; }
                }
                if (kind == 0 || kind == 1 || kind == 4) {
                    float ss = 0.f;
#pragma unroll
                    for (int bj = 0; bj < 2; ++bj)
#pragma unroll
                        for (int j = 0; j < 8; ++j) ss += x[bj][j] * x[bj][j];
                    ss += __shfl_xor(ss, 16); ss += __shfl_xor(ss, 32);
                    const float rinv = rsqrtf(ss * (1.0f / 64.0f) + EPS);
#pragma unroll
                    for (int bj = 0; bj < 2; ++bj)
#pragma unroll
                        for (int j = 0; j < 8; ++j) x[bj][j] = x[bj][j] * rinv * nw[bj][j];
                }
                if (kind == 0 || kind == 1) {
                    const int pos = row < SEQ ? row : SEQ;
                    const float* rp = rope + ((size_t)pos * 32 + 8 * fq) * 2;
                    float cs[16];
#pragma unroll
                    for (int t = 0; t < 4; ++t) { const f32x4 v = ok ? *(const f32x4*)(rp + 4 * t) : (f32x4){1.f, 0.f, 1.f, 0.f}; cs[4 * t] = v[0]; cs[4 * t + 1] = v[1]; cs[4 * t + 2] = v[2]; cs[4 * t + 3] = v[3]; }
#pragma unroll
                    for (int j = 0; j < 8; ++j) { const float c = cs[2 * j], s = cs[2 * j + 1], a = x[0][j], b = x[1][j]; x[0][j] = a * c - b * s; x[1][j] = b * c + a * s; }
                }
                if (ok) {
                    bf16* dst; int ld;
                    if (kind == 0) { dst = Qb; ld = 512; } else if (kind == 1) { dst = Kb; ld = 128; } else if (kind == 2) { dst = Vb; ld = 128; } else if (kind == 3) { dst = Ub; ld = 512; } else { dst = GVb; ld = 512; }
                    bf16* rowp = dst + (size_t)row * ld + head * 64 + 8 * fq;
#pragma unroll
                    for (int bj = 0; bj < 2; ++bj) { u32x4 w; w.x = pk2(x[bj][0], x[bj][1]); w.y = pk2(x[bj][2], x[bj][3]); w.z = pk2(x[bj][4], x[bj][5]); w.w = pk2(x[bj][6], x[bj][7]); *(u32x4*)(rowp + 32 * bj) = w; }
                    float* fo = nullptr;
                    if (kind == 1 || kind == 2) {
                        if (row >= SEQ) fo = out + (kind == 1 ? O_NKS : O_NVS) + ((size_t)(row - SEQ) * 128 + 127) * 128 + head * 64;
                        else if (row >= SEQ - 128) fo = out + (kind == 1 ? O_NKP : O_NVP) + (size_t)(row - (SEQ - 128)) * 128 + head * 64;
                    } else if (kind == 4 && row >= SEQ) fo = out + O_NGV + (size_t)(row - SEQ) * 512 + head * 64;
                    if (fo) {
#pragma unroll
                        for (int bj = 0; bj < 2; ++bj) { *(f32x4*)(fo + 32 * bj + 8 * fq) = (f32x4){x[bj][0], x[bj][1], x[bj][2], x[bj][3]}; *(f32x4*)(fo + 32 * bj + 8 * fq + 4) = (f32x4){x[bj][4], x[bj][5], x[bj][6], x[bj][7]}; }
                    }
                }
            }
    }
};

struct EpiOut {
    static constexpr bool PERM = false, AFTER_DRAIN = false;
    const float *xp, *xs; float* out; bf16* HN; float* rowss;
    __device__ __forceinline__ void operator()(const pg8::f32x4 (&acc)[2][2][4][2], const pg8::Unit& u, int wr, int wc, int fr, int fq) const {
#pragma unroll
        for (int ai = 0; ai < 2; ++ai)
#pragma unroll
            for (int m = 0; m < 4; ++m) {
                const int row = u.pm * 256 + ai * 128 + wr * 64 + m * 16 + fr;
                const bool ok = row < MTOK;
                const float* xr = xrow_ptr(xp, xs, ok ? row : 0);
                float ss = 0.f;
#pragma unroll
                for (int bj = 0; bj < 2; ++bj)
#pragma unroll
                    for (int n = 0; n < 2; ++n) {
                        const int col = u.pn * 256 + bj * 128 + wc * 32 + n * 16 + 4 * fq;
                        f32x4 h = acc[ai][bj][m][n];
                        if (ok) { h = h + *(const f32x4*)(xr + col); *(f32x4*)(out + (size_t)row * DM + col) = h;
                            u32x2 w; w.x = pk2(h[0], h[1]); w.y = pk2(h[2], h[3]); *(u32x2*)(HN + (size_t)row * DM + col) = w; }
                        ss += (h[0] * h[0] + h[1] * h[1]) + (h[2] * h[2] + h[3] * h[3]);
                    }
                ss += __shfl_xor(ss, 16); ss += __shfl_xor(ss, 32);
                if (ok && fq == 0) rowss[(size_t)row * 16 + u.pn * 4 + wc] = ss;
            }
    }
};

struct EpiQ {
    static constexpr bool PERM = true, AFTER_DRAIN = false;
    bf16* QP; const float* rowss;
    __device__ __forceinline__ void operator()(const pg8::f32x4 (&acc)[2][2][4][2], const pg8::Unit& u, int wr, int wc, int fr, int fq) const {
#pragma unroll
        for (int ai = 0; ai < 2; ++ai)
#pragma unroll
            for (int m = 0; m < 4; ++m) {
                const int row = u.pm * 256 + ai * 128 + wr * 64 + m * 16 + fr;
                if (row < MTOK) {
                    float ss = 0.f;
#pragma unroll
                    for (int t = 0; t < 4; ++t) { const f32x4 v = *(const f32x4*)(rowss + (size_t)row * 16 + 4 * t); ss += (v[0] + v[1]) + (v[2] + v[3]); }
                    const float r2 = rsqrtf(ss * (1.0f / 1024.0f) + EPS);
#pragma unroll
                    for (int bj = 0; bj < 2; ++bj) { const f32x4 a = acc[ai][bj][m][0] * r2, b = acc[ai][bj][m][1] * r2;
                        u32x4 w; w.x = pk2(a[0], a[1]); w.y = pk2(a[2], a[3]); w.z = pk2(b[0], b[1]); w.w = pk2(b[2], b[3]);
                        *(u32x4*)(QP + (size_t)row * NQ + u.pn * 256 + bj * 128 + wc * 32 + 8 * fq) = w; }
                }
            }
    }
};

__device__ __forceinline__ void p0_transpose_item(const float* W, const float* fold, int K, int N, bf16* WT, bool perm, LAS float* scr, int item, int lane) {
    const int nblk = N / 32, kb = item / nblk, nb = item % nblk, k0 = 64 * kb, n0 = 32 * nb;
    int l0 = n0;
    if (perm) { const int t = n0 & ~255, loc = n0 & 255, bj = loc >> 7, wc = (loc >> 5) & 3; l0 = t + 64 * wc + 32 * bj; }
#pragma unroll 8
    for (int i = 0; i < 32; ++i) { const int kk = 2 * i + (lane >> 5); scr[kk * 33 + (lane & 31)] = W[(size_t)(k0 + kk) * N + l0 + (lane & 31)] * fold[k0 + kk]; }
    asm volatile("s_waitcnt lgkmcnt(0)" ::: "memory");
    const int c = lane & 7;
#pragma unroll
    for (int j = 0; j < 4; ++j) { const int n = (lane >> 3) + 8 * j; const LAS float* s = scr + (8 * c) * 33 + n;
        u32x4 o; o.x = pk2(s[0 * 33], s[1 * 33]); o.y = pk2(s[2 * 33], s[3 * 33]); o.z = pk2(s[4 * 33], s[5 * 33]); o.w = pk2(s[6 * 33], s[7 * 33]);
        *(u32x4*)(WT + (size_t)(n0 + n) * K + k0 + 8 * c) = o; }
    asm volatile("s_waitcnt lgkmcnt(0)" ::: "memory");
}

__device__ __forceinline__ void p0_prologue(Frame& F) {
    LAS float* scr = (LAS float*)(F.lds + F.wave * 16384);
    const int gw = F.bid * NWAVES + F.wave, NGW = F.G * NWAVES, lane = F.lane;
    const int gt = F.bid * 512 + F.tid, NGT = F.G * 512;
    const float* const* in = F.in;
    unsigned char* ws = F.ws;
    { constexpr int I_IN = 16 * (DIN / 32), I_O = 16 * (DM / 32), I_Q = 16 * (NQ / 32);
      for (int it = gw; it < I_IN + I_O + I_Q; it += NGW) {
          int r = it;
          if (r < I_IN) { p0_transpose_item(in[5], in[4], DM, DIN, (bf16*)(ws + WS_WIN), true, scr, r, lane); continue; } r -= I_IN;
          if (r < I_O) { p0_transpose_item(in[13], in[12], DM, DM, (bf16*)(ws + WS_WO), false, scr, r, lane); continue; } r -= I_O;
          p0_transpose_item(in[15], in[14], DM, NQ, (bf16*)(ws + WS_WQ), false, scr, r, lane);
      } }
    for (int row = gw; row < MP; row += NGW) {
        bf16* o0 = (bf16*)(ws + WS_A0) + (size_t)row * DM;
        if (row < MTOK) {
            const f32x4* xr = (const f32x4*)xrow_ptr(in[0], in[1], row) + lane;
            f32x4 v[4]; float s = 0.f;
#pragma unroll
            for (int j = 0; j < 4; ++j) { v[j] = xr[64 * j]; s += (v[j][0] * v[j][0] + v[j][1] * v[j][1]) + (v[j][2] * v[j][2] + v[j][3] * v[j][3]); }
            const float r1 = rsqrtf(wave_sum(s) * (1.0f / DM) + EPS);
#pragma unroll
            for (int j = 0; j < 4; ++j) { u32x2 w; w.x = pk2(v[j][0] * r1, v[j][1] * r1); w.y = pk2(v[j][2] * r1, v[j][3] * r1); ((u32x2*)o0)[64 * j + lane] = w; }
        } else {
            bf16* o1 = (bf16*)(ws + WS_A1) + (size_t)row * DM;
#pragma unroll
            for (int j = 0; j < 4; ++j) { ((u32x2*)o0)[64 * j + lane] = (u32x2){0u, 0u}; ((u32x2*)o1)[64 * j + lane] = (u32x2){0u, 0u}; }
        }
    }
    for (int row = gw; row < 2 * NEXP; row += NGW) {
        const int e = row & (NEXP - 1); const bool isv = row >= NEXP;
        const float* src = (isv ? in[18] : in[17]) + (size_t)e * DM;
        unsigned char* dst = ws + (isv ? WS_EV : WS_EU);
        f32x4 v[4]; float am = 0.f;
#pragma unroll
        for (int j = 0; j < 4; ++j) { v[j] = ((const f32x4*)src)[64 * j + lane]; am = fmaxf(am, fmaxf(fmaxf(fabsf(v[j][0]), fabsf(v[j][1])), fmaxf(fabsf(v[j][2]), fabsf(v[j][3])))); }
        am = wave_max(am);
        const float sc = am > 0.f ? am * (1.0f / 127.0f) : 1.0f, isc = 1.0f / sc;
        if (lane == 0) ((float*)(ws + WS_SU))[row] = sc;
        const unsigned bias = isv ? 0x80808080u : 0u;
#pragma unroll
        for (int j = 0; j < 4; ++j) {
            const int q0 = (int)rintf(v[j][0] * isc), q1 = (int)rintf(v[j][1] * isc), q2 = (int)rintf(v[j][2] * isc), q3 = (int)rintf(v[j][3] * isc);
            const unsigned w = ((unsigned)q0 & 255u) | (((unsigned)q1 & 255u) << 8) | (((unsigned)q2 & 255u) << 16) | (((unsigned)q3 & 255u) << 24);
            *(unsigned*)(dst + ((size_t)(2 * j + (lane >> 5)) * NEXP + e) * 128 + 4 * (lane & 31)) = w ^ bias;
        }
    }
    for (int i = gt; i < 262144 / 4; i += NGT) { const f32x4 v = ((const f32x4*)in[16])[i]; u32x2 w; w.x = pk2(v[0], v[1]); w.y = pk2(v[2], v[3]); ((u32x2*)(ws + WS_SK))[i] = w; }
    for (int i = gt; i < 131072 / 4; i += NGT) { f32x4 v = ((const f32x4*)in[10])[i]; const int e0 = 4 * i, t = (e0 >> 7) & 127, s0 = e0 & 127;
        if (s0 + 0 > t) v[0] = 0.f; if (s0 + 1 > t) v[1] = 0.f; if (s0 + 2 > t) v[2] = 0.f; if (s0 + 3 > t) v[3] = 0.f;
        u32x2 w; w.x = pk2(v[0], v[1]); w.y = pk2(v[2], v[3]); ((u32x2*)(ws + WS_WSB))[i] = w; }
    for (int i = gt; i < 16385 * 32; i += NGT) { const int pos = i >> 5, fi = i & 31;
        const float inv = (float)exp2(-(double)fi * (13.287712379549449 / 32.0));
        const float ang = (float)pos * inv;
        double s, c; sincos((double)ang, &s, &c);
        ((f32x2*)(ws + WS_ROPE))[i] = (f32x2){(float)c, (float)s}; }
    for (int i = gt; i < 2 * NSMP * (127 * 128 / 4); i += NGT) { const int kv = i / (NSMP * 4064), r = i % (NSMP * 4064), b = r / 4064, o = r % 4064;
        const f32x4 v = ((const f32x4*)((kv ? in[3] : in[2]) + (size_t)b * 16384 + 128))[o];
        ((f32x4*)(F.out + (kv ? O_NVS : O_NKS) + (size_t)b * 16384))[o] = v; }
}

constexpr int VS_STRIDE = 272, GS_STRIDE = 1040, RED_OFF = 143360;

__device__ __forceinline__ void store_norm_tile(const f32x16 (&O)[2], float scale, bf16* base  , int h) {
#pragma unroll
    for (int dt = 0; dt < 2; ++dt)
#pragma unroll
        for (int g = 0; g < 4; ++g) { u32x2 w; w.x = pk2(O[dt][4 * g] * scale, O[dt][4 * g + 1] * scale); w.y = pk2(O[dt][4 * g + 2] * scale, O[dt][4 * g + 3] * scale);
            *(u32x2*)(base + 32 * dt + 8 * g + 4 * h) = w; }
}

__device__ __forceinline__ void attn_unit(Frame& F, int tq) {
    const int t0 = 32 * tq, w = F.wave, lane = F.lane, r = lane & 31, h = lane >> 5, kvh = w >> 2;
    const bf16* Qb = (const bf16*)(F.ws + WS_QB); const bf16* Kb = (const bf16*)(F.ws + WS_KB); const bf16* Vb = (const bf16*)(F.ws + WS_VB);
    LAS unsigned char* vs = F.lds; LAS float* red = (LAS float*)(F.lds + RED_OFF);
    for (int ci = F.tid; ci < 160 * 16; ci += 512) { const int ks = ci >> 4, c16 = ci & 15, pos = t0 - 128 + ks;
        u32x4 v = (u32x4){0u, 0u, 0u, 0u}; if (pos >= 0) v = *(const u32x4*)(Vb + (size_t)pos * 128 + c16 * 8);
        *(LAS u32x4*)(vs + ks * VS_STRIDE + c16 * 16) = v; }
    bf16x8 qf[4];
#pragma unroll
    for (int ks = 0; ks < 4; ++ks) qf[ks] = *(const bf16x8*)(Qb + (size_t)(t0 + r) * 512 + w * 64 + 16 * ks + 8 * h);
    f32x16 S[5];
#pragma unroll
    for (int kt = 0; kt < 5; ++kt) {
#pragma unroll
        for (int i = 0; i < 16; ++i) S[kt][i] = 0.f;
        int kp = t0 - 128 + 32 * kt + r; kp = kp < 0 ? 0 : kp;
#pragma unroll
        for (int ks = 0; ks < 4; ++ks) { const bf16x8 kf = *(const bf16x8*)(Kb + (size_t)kp * 128 + kvh * 64 + 16 * ks + 8 * h); S[kt] = MFMA32(kf, qf[ks], S[kt]); }
    }
    const float sink = F.in[8][w];
    float mx = sink;
    const int pq = t0 + r;
#pragma unroll
    for (int kt = 0; kt < 5; ++kt)
#pragma unroll
        for (int i = 0; i < 16; ++i) { const int pk = t0 - 128 + 32 * kt + crow(i, h); const bool valid = (pk >= 0) && (pk <= pq) && (pk >= pq - 127);
            const float s = valid ? S[kt][i] * 0.125f : -1e30f; S[kt][i] = s; mx = fmaxf(mx, s); }
    mx = fmaxf(mx, __shfl_xor(mx, 32));
    float sum = 0.f;
#pragma unroll
    for (int kt = 0; kt < 5; ++kt)
#pragma unroll
        for (int i = 0; i < 16; ++i) { const float p = __expf(S[kt][i] - mx); S[kt][i] = p; sum += p; }
    sum += __shfl_xor(sum, 32); sum += __expf(sink - mx);
    const float inv = 1.0f / sum;
    __syncthreads();
    f32x16 O[2];
#pragma unroll
    for (int i = 0; i < 16; ++i) { O[0][i] = 0.f; O[1][i] = 0.f; }
    const int q = (lane & 15) >> 2, p4 = lane & 3, blk = (lane >> 4) & 1;
#pragma unroll
    for (int kt = 0; kt < 5; ++kt)
#pragma unroll
        for (int s = 0; s < 2; ++s) {
            u32x4 pw; pw.x = pk2(S[kt][8 * s], S[kt][8 * s + 1]); pw.y = pk2(S[kt][8 * s + 2], S[kt][8 * s + 3]); pw.z = pk2(S[kt][8 * s + 4], S[kt][8 * s + 5]); pw.w = pk2(S[kt][8 * s + 6], S[kt][8 * s + 7]);
            const bf16x8 pb = __builtin_bit_cast(bf16x8, pw);
#pragma unroll
            for (int dt = 0; dt < 2; ++dt) {
                LAS unsigned char* a0 = vs + (32 * kt + 16 * s + 4 * h + q) * VS_STRIDE + (kvh * 64 + 32 * dt + 16 * blk + 4 * p4) * 2;
                const s16x4 lo = vtr(a0), hi = vtr(a0 + 8 * VS_STRIDE);
                const bf16x8 va = __builtin_shufflevector(lo, hi, 0, 1, 2, 3, 4, 5, 6, 7);
                O[dt] = MFMA32(va, pb, O[dt]);
            }
        }
    float ss = 0.f;
#pragma unroll
    for (int dt = 0; dt < 2; ++dt)
#pragma unroll
        for (int i = 0; i < 16; ++i) { O[dt][i] *= inv; ss += O[dt][i] * O[dt][i]; }
    ss += __shfl_xor(ss, 32);
    if (h == 0) red[w * 32 + r] = ss;
    __syncthreads();
    float tot = 0.f;
#pragma unroll
    for (int ww = 0; ww < 8; ++ww) tot += red[ww * 32 + r];
    const float rn = rsqrtf(tot * (1.0f / 512.0f) + EPS);
    store_norm_tile(O, rn, (bf16*)(F.ws + WS_A1) + (size_t)(t0 + r) * DM + w * 64, h);
    __syncthreads();
}

__device__ __forceinline__ void gate_unit(Frame& F, int tg) {
    const int chunk = tg >> 2, j = tg & 3, tl0 = 32 * j, g0 = 128 * chunk + tl0, nrows = tl0 + 32;
    const int w = F.wave, lane = F.lane, r = lane & 31, h = lane >> 5;
    const bf16* GVb = (const bf16*)(F.ws + WS_GVB); const bf16* Ub = (const bf16*)(F.ws + WS_UB); const bf16* WsB = (const bf16*)(F.ws + WS_WSB);
    LAS unsigned char* gs = F.lds; LAS float* red = (LAS float*)(F.lds + RED_OFF);
    for (int ci = F.tid; ci < nrows * 64; ci += 512) { const int row = ci >> 6, c16 = ci & 63;
        *(LAS u32x4*)(gs + row * GS_STRIDE + c16 * 16) = *(const u32x4*)(GVb + (size_t)(128 * chunk + row) * 512 + c16 * 8); }
    __syncthreads();
    f32x16 Y[2];
#pragma unroll
    for (int i = 0; i < 16; ++i) { Y[0][i] = 0.f; Y[1][i] = 0.f; }
    const int q = (lane & 15) >> 2, p4 = lane & 3, blk = (lane >> 4) & 1;
    const int nks = nrows >> 4;
    for (int ks = 0; ks < nks; ++ks) {
        const bf16x8 wf = *(const bf16x8*)(WsB + (size_t)(w * 128 + tl0 + r) * 128 + 16 * ks + 8 * h);
#pragma unroll
        for (int dt = 0; dt < 2; ++dt) {
            LAS unsigned char* a0 = gs + (16 * ks + 8 * h + q) * GS_STRIDE + (w * 64 + 32 * dt + 16 * blk + 4 * p4) * 2;
            const s16x4 lo = vtr(a0), hi = vtr(a0 + 4 * GS_STRIDE);
            const bf16x8 ga = __builtin_shufflevector(lo, hi, 0, 1, 2, 3, 4, 5, 6, 7);
            Y[dt] = MFMA32(ga, wf, Y[dt]);
        }
    }
    const float bias = F.in[11][w * 128 + tl0 + r];
    float ss = 0.f;
#pragma unroll
    for (int dt = 0; dt < 2; ++dt)
#pragma unroll
        for (int g = 0; g < 4; ++g) { const u16x4 uu = *(const u16x4*)(Ub + (size_t)(g0 + r) * 512 + w * 64 + 32 * dt + 8 * g + 4 * h);
#pragma unroll
            for (int e = 0; e < 4; ++e) { const float v = bf2f(uu[e]) * (Y[dt][4 * g + e] + bias); Y[dt][4 * g + e] = v; ss += v * v; } }
    ss += __shfl_xor(ss, 32);
    if (h == 0) red[w * 32 + r] = ss;
    __syncthreads();
    float tot = 0.f;
#pragma unroll
    for (int ww = 0; ww < 8; ++ww) tot += red[ww * 32 + r];
    const float rn = rsqrtf(tot * (1.0f / 512.0f) + EPS);
    store_norm_tile(Y, rn, (bf16*)(F.ws + WS_A1) + (size_t)(g0 + r) * DM + 512 + w * 64, h);
    __syncthreads();
}

__device__ __forceinline__ void sample_unit(Frame& F, int b) {
    const int row = SEQ + b, w = F.wave, lane = F.lane, kvh = w >> 2;
    const bf16* Qb = (const bf16*)(F.ws + WS_QB); const bf16* Ub = (const bf16*)(F.ws + WS_UB);
    LAS float* qs = (LAS float*)F.lds + w * 64; LAS float* ps = (LAS float*)(F.lds + 2048) + w * 128; LAS float* red = (LAS float*)(F.lds + RED_OFF);
    qs[lane] = bf2f(Qb[(size_t)row * 512 + w * 64 + lane]);
    __syncthreads();
    const float* ck = F.in[2]; const float* cv = F.in[3];
    float s[2];
#pragma unroll
    for (int i = 0; i < 2; ++i) { const int sj = 1 + lane + 64 * i;
        const float* kp = sj < 128 ? ck + ((size_t)(b * 128 + sj) * 2 + kvh) * 64 : F.out + O_NKS + ((size_t)(b * 128 + 127) * 2 + kvh) * 64;
        float d = 0.f;
#pragma unroll
        for (int c = 0; c < 16; ++c) { const f32x4 kk = ((const f32x4*)kp)[c]; const f32x4 qq = ((LAS f32x4*)qs)[c]; d += (kk[0] * qq[0] + kk[1] * qq[1]) + (kk[2] * qq[2] + kk[3] * qq[3]); }
        s[i] = d * 0.125f; }
    const float sink = F.in[8][w];
    const float mx = fmaxf(wave_max(fmaxf(s[0], s[1])), sink);
    const float p0 = __expf(s[0] - mx), p1 = __expf(s[1] - mx);
    const float sum = wave_sum(p0 + p1) + __expf(sink - mx);
    ps[lane] = p0; ps[64 + lane] = p1;
    __syncthreads();
    float o = 0.f;
    for (int kk = 0; kk < 128; ++kk) { const int sj = kk + 1;
        const float* vp = sj < 128 ? cv + ((size_t)(b * 128 + sj) * 2 + kvh) * 64 : F.out + O_NVS + ((size_t)(b * 128 + 127) * 2 + kvh) * 64;
        o += ps[kk] * vp[lane]; }
    o /= sum;
    const float uu = bf2f(Ub[(size_t)row * 512 + w * 64 + lane]);
    const float gvv = F.out[O_NGV + (size_t)b * 512 + w * 64 + lane];
    const float gm = uu * (F.in[10][(size_t)w * 16384] * gvv + F.in[11][w * 128]);
    const float ssa = wave_sum(o * o), ssg = wave_sum(gm * gm);
    if (lane == 0) { red[w] = ssa; red[8 + w] = ssg; }
    __syncthreads();
    float ta = 0.f, tg2 = 0.f;
#pragma unroll
    for (int ww = 0; ww < 8; ++ww) { ta += red[ww]; tg2 += red[8 + ww]; }
    bf16* mix = (bf16*)(F.ws + WS_A1) + (size_t)row * DM;
    mix[w * 64 + lane] = (bf16)f2bf(o * rsqrtf(ta * (1.0f / 512.0f) + EPS));
    mix[512 + w * 64 + lane] = (bf16)f2bf(gm * rsqrtf(tg2 * (1.0f / 512.0f) + EPS));
    __syncthreads();
}

__device__ __forceinline__ int f2key(float f) { const int b = __builtin_bit_cast(int, f); return b ^ ((b >> 31) & 0x7fffffff); }
__device__ __forceinline__ float key2f(int k) { return __builtin_bit_cast(float, k ^ ((k >> 31) & 0x7fffffff)); }
__device__ __forceinline__ void ce_desc(int& a, int& b) { const int hi = a > b ? a : b, lo = a > b ? b : a; a = hi; b = lo; }
__device__ __forceinline__ void sort16_desc(int (&a)[16]) {
#pragma unroll
    for (int k = 2; k <= 16; k <<= 1)
#pragma unroll
        for (int j = k >> 1; j > 0; j >>= 1)
#pragma unroll
            for (int i = 0; i < 16; ++i) { const int l = i ^ j; if (l > i) { if ((i & k) == 0) ce_desc(a[i], a[l]); else ce_desc(a[l], a[i]); } }
}
__device__ __forceinline__ void merge16_desc(int (&a)[16], const int (&b)[16]) {
#pragma unroll
    for (int i = 0; i < 16; ++i) a[i] = a[i] > b[15 - i] ? a[i] : b[15 - i];
#pragma unroll
    for (int j = 8; j > 0; j >>= 1)
#pragma unroll
        for (int i = 0; i < 16; ++i) { const int l = i ^ j; if (l > i) ce_desc(a[i], a[l]); }
}

__device__ __forceinline__ void route_list(const unsigned char* qbase  , const unsigned char* kbase  , unsigned voffq, unsigned voffk, int (&out)[16]) {
    f32x16 acc[4];
#pragma unroll
    for (int mt = 0; mt < 4; ++mt)
#pragma unroll
        for (int i = 0; i < 16; ++i) acc[mt][i] = 0.f;
#pragma unroll 2
    for (int ks = 0; ks < 8; ++ks) {
        const bf16x8 bq = *(const bf16x8*)(qbase + ks * 32 + voffq);
#pragma unroll
        for (int mt = 0; mt < 4; ++mt) { const bf16x8 ak = *(const bf16x8*)(kbase + mt * 8192 + ks * 32 + voffk); acc[mt] = MFMA32(ak, bq, acc[mt]); }
    }
    int k1[16];
#pragma unroll
    for (int i = 0; i < 16; ++i) { out[i] = (f2key(acc[0][i]) & ~127) | (crow(i, 0)); k1[i] = (f2key(acc[1][i]) & ~127) | (32 + crow(i, 0)); }
    sort16_desc(out); sort16_desc(k1); merge16_desc(out, k1);
    int k2[16];
#pragma unroll
    for (int i = 0; i < 16; ++i) { k2[i] = (f2key(acc[2][i]) & ~127) | (64 + crow(i, 0)); k1[i] = (f2key(acc[3][i]) & ~127) | (96 + crow(i, 0)); }
    sort16_desc(k2); sort16_desc(k1); merge16_desc(k2, k1); merge16_desc(out, k2);
}

__device__ __forceinline__ void route_task(Frame& F, int tg, int hp) {
    const int lane = F.lane, r = lane & 31, h = lane >> 5, w = F.wave;
    const int token = 32 * tg + r;
    const unsigned char* QPu = F.ws + WS_QP + ((size_t)(32 * tg) * NQ + (2 * hp) * 256) * 2;
    const unsigned char* SKu = F.ws + WS_SK + (size_t)((2 * hp) * 2 * 128) * 128 * 2;
    const unsigned voffq = (unsigned)(r * NQ + 8 * h) * 2u, voffk = (unsigned)(r * 128 + 8 * h) * 2u;
    const int h4 = 4 * h;
    int T[2][16];
#pragma unroll
    for (int p = 0; p < 2; ++p) {
        int La[16], Lb[16];
        route_list(QPu + p * 256, SKu + p * 32768, voffq, voffk, La);
        __builtin_amdgcn_sched_barrier(0);
        route_list(QPu + 512 + p * 256, SKu + 65536 + p * 32768, voffq, voffk, Lb);
        __builtin_amdgcn_sched_barrier(0);
        int other[16];
#pragma unroll
        for (int i = 0; i < 16; ++i) { const int send = h ? La[i] : Lb[i]; other[i] = __shfl_xor(send, 32) | (4 - h4); T[p][i] = (h ? Lb[i] : La[i]) | h4; }
        merge16_desc(T[p], other);
        __builtin_amdgcn_sched_barrier(0);
    }
    const int head = 2 * hp + h;
    float v1[16], v2[16];
#pragma unroll
    for (int i = 0; i < 16; ++i) { v1[i] = key2f(T[0][i]); v2[i] = key2f(T[1][i]); }
    int c0[16], c1[16], c2[16], c3[16];
    {
        int n = 0;
#pragma unroll
        for (int i = 0; i < 16; ++i)
#pragma unroll
            for (int j = 0; j < 16; ++j) if ((i + 1) * (j + 1) <= 16) {
                const int key = (f2key(v1[i] + v2[j]) & ~255) | (i * 16 + j);
                if (n < 16) c0[n] = key; else if (n < 32) c1[n - 16] = key; else if (n < 48) c2[n - 32] = key; else c3[n - 48] = key;
                ++n;
            }
#pragma unroll
        for (int t = 2; t < 16; ++t) c3[t] = (int)0x80000000;
    }
    sort16_desc(c0); sort16_desc(c1); sort16_desc(c2); sort16_desc(c3);
    merge16_desc(c0, c1); merge16_desc(c2, c3); merge16_desc(c0, c2);
    LAS unsigned* ib = (LAS unsigned*)(F.lds + w * 2048 + lane * 32);
#pragma unroll
    for (int p = 0; p < 2; ++p)
#pragma unroll
        for (int d = 0; d < 4; ++d) ib[p * 4 + d] = (unsigned)(T[p][4 * d] & 127) | ((unsigned)(T[p][4 * d + 1] & 127) << 8) | ((unsigned)(T[p][4 * d + 2] & 127) << 16) | ((unsigned)(T[p][4 * d + 3] & 127) << 24);
    float best[16]; int ex[16];
    LAS unsigned char* ibb = (LAS unsigned char*)ib;
#pragma unroll
    for (int k = 0; k < 16; ++k) { best[k] = key2f(c0[k]); const int tag = c0[k] & 255; ex[k] = (int)ibb[tag >> 4] * 128 + (int)ibb[16 + (tag & 15)]; }
    float den = 0.f;
#pragma unroll
    for (int k = 0; k < 16; ++k) { best[k] = __expf(best[k] - key2f(c0[0])); den += best[k]; }
    const float rd = 1.0f / den;
    if (token < MTOK) {
        u32x4* di = (u32x4*)(F.ws + WS_RID + ((size_t)token * 128 + head * 16) * 2);
        di[0] = (u32x4){(unsigned)ex[0] | ((unsigned)ex[1] << 16), (unsigned)ex[2] | ((unsigned)ex[3] << 16), (unsigned)ex[4] | ((unsigned)ex[5] << 16), (unsigned)ex[6] | ((unsigned)ex[7] << 16)};
        di[1] = (u32x4){(unsigned)ex[8] | ((unsigned)ex[9] << 16), (unsigned)ex[10] | ((unsigned)ex[11] << 16), (unsigned)ex[12] | ((unsigned)ex[13] << 16), (unsigned)ex[14] | ((unsigned)ex[15] << 16)};
        f32x4* dg = (f32x4*)(F.ws + WS_RG + ((size_t)token * 128 + head * 16) * 4);
#pragma unroll
        for (int k = 0; k < 16; k += 4) dg[k >> 2] = (f32x4){best[k] * rd, best[k + 1] * rd, best[k + 2] * rd, best[k + 3] * rd};
    }
}

typedef __bf16 bf16x2v __attribute__((ext_vector_type(2)));
__device__ __forceinline__ float dot2bf(unsigned a, unsigned b, float acc) { return __builtin_amdgcn_fdot2_f32_bf16(__builtin_bit_cast(bf16x2v, a), __builtin_bit_cast(bf16x2v, b), acc, false); }
template <int CTRL> __device__ __forceinline__ float dpp_f(float v) { return __builtin_bit_cast(float, __builtin_amdgcn_update_dpp(0, __builtin_bit_cast(int, v), CTRL, 0xf, 0xf, false)); }
__device__ __forceinline__ float rowsum16(float v) {
    v += dpp_f<0x128>(v);
    v += dpp_f<0x141>(v);
    v += dpp_f<0x4E>(v);
    v += dpp_f<0xB1>(v);
    return v;
}
template <int CTRL> __device__ __forceinline__ int dpp_i(int v) { return __builtin_amdgcn_update_dpp(0, v, CTRL, 0xf, 0xf, false); }
__device__ __forceinline__ void st_f32x4_nt(float* p, f32x4 v) { asm volatile("global_store_dwordx4 %0, %1, off\n\ts_nop 1" :: "v"(p), "v"(v)); }
__device__ __forceinline__ void st_f32_nt(float* p, float v) { asm volatile("global_store_dword %0, %1, off\n\ts_nop 1" :: "v"(p), "v"(v)); }
struct UMeta { int idpk; f32x4 h[4]; f32x4 rs[4]; };
struct UTok { int xq[4]; float sx; };
__device__ __forceinline__ UMeta u_load_meta(Frame& F, int t, int x, int lane, int c) {
    UMeta m;
    const unsigned short* idp = (const unsigned short*)(F.ws + WS_RID) + (size_t)t * 128 + lane;
    m.idpk = (int)idp[0] | ((int)idp[64] << 16);
    const float* hp = F.out + (size_t)t * DM + 128 * x + 16 * c;
    const float* rs = (const float*)(F.ws + WS_ROWSS) + (size_t)t * 16;
#pragma unroll
    for (int q = 0; q < 4; ++q) { m.h[q] = *(const f32x4*)(hp + 4 * q); m.rs[q] = *(const f32x4*)(rs + 4 * q); }
    return m;
}
__device__ __forceinline__ UTok u_quant(const UMeta& m, const float (&nfv)[16]) {
    float ss = 0.f;
#pragma unroll
    for (int q = 0; q < 4; ++q) ss += (m.rs[q][0] + m.rs[q][1]) + (m.rs[q][2] + m.rs[q][3]);
    const float r2 = rsqrtf(ss * (1.0f / DM) + EPS);
    float xv[16]; float am = 0.f;
#pragma unroll
    for (int q = 0; q < 4; ++q)
#pragma unroll
        for (int e = 0; e < 4; ++e) { xv[4 * q + e] = m.h[q][e] * r2 * nfv[4 * q + e]; am = fmaxf(am, fabsf(xv[4 * q + e])); }
    am = fmaxf(am, dpp_f<0x141>(am)); am = fmaxf(am, dpp_f<0x4E>(am)); am = fmaxf(am, dpp_f<0xB1>(am));
    UTok u; u.sx = am > 0.f ? am * (1.0f / 127.0f) : 1.0f; const float isx = 1.0f / u.sx;
#pragma unroll
    for (int q = 0; q < 4; ++q) { const int q0 = (int)rintf(xv[4 * q] * isx), q1 = (int)rintf(xv[4 * q + 1] * isx), q2 = (int)rintf(xv[4 * q + 2] * isx), q3 = (int)rintf(xv[4 * q + 3] * isx);
        u.xq[q] = (int)(((unsigned)q0 & 255u) | (((unsigned)q1 & 255u) << 8) | (((unsigned)q2 & 255u) << 16) | (((unsigned)q3 & 255u) << 24)); }
    return u;
}
__device__ __forceinline__ void issue_rows(const unsigned char* slab, int idpk, int g, int hsh, u32x4 (&rows)[16]) {
#pragma unroll
    for (int i = 0; i < 16; ++i) { const int v = __shfl(idpk, 16 * (g & 3) + i); const int e = (v >> hsh) & 0xffff;
#if VPROBE == 1
        rows[i] = (u32x4){(unsigned)e, (unsigned)e * 3u, (unsigned)e * 5u, (unsigned)e * 7u};
#else
        rows[i] = *(const u32x4*)(slab + (size_t)e * 128);
#endif
    }
}
__device__ __forceinline__ void u_compute(Frame& F, const UTok& u, const u32x4 (&rows)[16], int t, int x, int g, int c, bool valid) {
    float res0 = 0.f, res1 = 0.f;
#pragma unroll
    for (int i = 0; i < 16; ++i) {
        int d = __builtin_amdgcn_sdot4((int)rows[i][0], u.xq[0], 0, false); d = __builtin_amdgcn_sdot4((int)rows[i][1], u.xq[1], d, false);
        d = __builtin_amdgcn_sdot4((int)rows[i][2], u.xq[2], d, false); d = __builtin_amdgcn_sdot4((int)rows[i][3], u.xq[3], d, false);
        d += dpp_i<0x141>(d); d += dpp_i<0x4E>(d); d += dpp_i<0xB1>(d);
        const float df = (float)d * u.sx;
        if (i < 8) res0 = (c == (i & 7)) ? df : res0; else res1 = (c == (i & 7)) ? df : res1;
    }
    if (valid) { float* pp = (float*)(F.ws + WS_PART) + ((size_t)x * MTOK + t) * 128 + 16 * g + c; st_f32_nt(pp, res0); st_f32_nt(pp + 8, res1); }
}
__device__ __forceinline__ void upass(Frame& F, int x, int t_first, int stride) {
    const int lane = F.lane, g = lane >> 3, c = lane & 7, hsh = (g >> 2) * 16;
    const unsigned char* slab = F.ws + WS_EU + (size_t)x * NEXP * 128 + 16 * c;
    float nfv[16];
    { const float* nf = F.in[14] + 128 * x + 16 * c;
#pragma unroll
      for (int q = 0; q < 4; ++q) { const f32x4 v = *(const f32x4*)(nf + 4 * q); nfv[4 * q] = v[0]; nfv[4 * q + 1] = v[1]; nfv[4 * q + 2] = v[2]; nfv[4 * q + 3] = v[3]; } }
#define TCL(t) ((t) < MTOK ? (t) : MTOK - 1)
    if (t_first >= MTOK) return;
    UMeta m0 = u_load_meta(F, TCL(t_first), x, lane, c), m1 = u_load_meta(F, TCL(t_first + stride), x, lane, c);
    u32x4 A[16], B[16];
    UTok ua = u_quant(m0, nfv), ub;
    issue_rows(slab, m0.idpk, g, hsh, A);
    for (int t = t_first; t < MTOK; t += 2 * stride) {
        m0 = u_load_meta(F, TCL(t + 2 * stride), x, lane, c);
        ub = u_quant(m1, nfv); issue_rows(slab, m1.idpk, g, hsh, B);
        u_compute(F, ua, A, t, x, g, c, true);
        m1 = u_load_meta(F, TCL(t + 3 * stride), x, lane, c);
        ua = u_quant(m0, nfv); issue_rows(slab, m0.idpk, g, hsh, A);
        u_compute(F, ub, B, t + stride, x, g, c, t + stride < MTOK);
    }
}

struct VMeta { int idpk; float w_lo, w_hi; };
__device__ __forceinline__ VMeta v_load_meta(Frame& F, int t, int lane) {
    VMeta m;
    const unsigned short* idp = (const unsigned short*)(F.ws + WS_RID) + (size_t)t * 128 + lane;
    m.idpk = (int)idp[0] | ((int)idp[64] << 16);
    const float* wp = (const float*)(F.ws + WS_RW) + (size_t)t * 128 + lane;
    m.w_lo = wp[0]; m.w_hi = wp[64];
    return m;
}
__device__ __forceinline__ void v_hload(Frame& F, int t, int x, int c, f32x4 (&hv)[4]) {
    const float* hp = F.out + (size_t)t * DM + 128 * x + 16 * c;
#pragma unroll
    for (int q = 0; q < 4; ++q) hv[q] = *(const f32x4*)(hp + 4 * q);
}
__device__ __forceinline__ void v_compute(Frame& F, const VMeta& m, const u32x4 (&rows)[16], const f32x4 (&hv)[4], int t, int x, int g, int c, bool valid) {
    float* hp = F.out + (size_t)t * DM + 128 * x + 16 * c;
    const bool hiw = g >= 4;
    float acc[16]; float sw = 0.f;
#pragma unroll
    for (int j = 0; j < 16; ++j) acc[j] = 0.f;
#pragma unroll
    for (int i = 0; i < 16; ++i) {
        const int src = 16 * (g & 3) + i;
        const float wl = __shfl(m.w_lo, src), wh = __shfl(m.w_hi, src);
        const float wv = hiw ? wh : wl;
        sw += wv;
#pragma unroll
        for (int k = 0; k < 4; ++k) { const unsigned rw_ = rows[i][k];
            acc[4 * k] += wv * (float)(rw_ & 255u); acc[4 * k + 1] += wv * (float)((rw_ >> 8) & 255u);
            acc[4 * k + 2] += wv * (float)((rw_ >> 16) & 255u); acc[4 * k + 3] += wv * (float)(rw_ >> 24); }
    }
#pragma unroll
    for (int j = 0; j < 16; ++j) { float a = acc[j] - 128.f * sw; a += dpp_f<0x128>(a); a += __shfl_xor(a, 16); a += __shfl_xor(a, 32); acc[j] = a; }
    if (g == 0 && valid) {
#pragma unroll
        for (int q = 0; q < 4; ++q) st_f32x4_nt(hp + 4 * q, (f32x4){hv[q][0] + acc[4 * q], hv[q][1] + acc[4 * q + 1], hv[q][2] + acc[4 * q + 2], hv[q][3] + acc[4 * q + 3]});
    }
}
__device__ __forceinline__ void vpass(Frame& F, int x, int t_first, int stride) {
    const int lane = F.lane, g = lane >> 3, c = lane & 7, hsh = (g >> 2) * 16;
    const unsigned char* slab = F.ws + WS_EV + (size_t)x * NEXP * 128 + 16 * c;
    if (t_first >= MTOK) return;
    VMeta m0 = v_load_meta(F, TCL(t_first), lane), m1 = v_load_meta(F, TCL(t_first + stride), lane), m2, m3;
    u32x4 A[16], B[16]; f32x4 hvA[4], hvB[4];
    issue_rows(slab, m0.idpk, g, hsh, A); v_hload(F, TCL(t_first), x, c, hvA);
    for (int t = t_first; t < MTOK; t += 2 * stride) {
        m2 = v_load_meta(F, TCL(t + 2 * stride), lane);
        issue_rows(slab, m1.idpk, g, hsh, B); v_hload(F, TCL(t + stride), x, c, hvB);
        v_compute(F, m0, A, hvA, t, x, g, c, true);
        m3 = v_load_meta(F, TCL(t + 3 * stride), lane);
        issue_rows(slab, m2.idpk, g, hsh, A); v_hload(F, TCL(t + 2 * stride), x, c, hvA);
        v_compute(F, m1, B, hvB, TCL(t + stride), x, g, c, t + stride < MTOK);
        m0 = m2; m1 = m3;
    }
#undef TCL
}

namespace cg = cooperative_groups;
constexpr int NPHASE = 9;
#ifndef VPROBE
#define VPROBE 0
#endif
#ifndef DUPMASK
#define DUPMASK 0
#endif
#ifndef SKIPMASK
#define SKIPMASK 0
#endif
#ifndef MK_BAR_KIND
#define MK_BAR_KIND 2
#endif

__global__ void __launch_bounds__(NWAVES * 64, 2) mk_fwd(Args args) {
    extern __shared__ __attribute__((aligned(16))) unsigned char lds_raw[];
    Frame F;
    F.lds = (LAS unsigned char*)lds_raw;
    F.tid = threadIdx.x; F.lane = F.tid & 63; F.wave = __builtin_amdgcn_readfirstlane(F.tid >> 6);
    F.G = gridDim.x; F.bid = blockIdx.x;
    F.in = args.in; F.out = args.out; F.ws = args.ws;
    volatile LAS unsigned* MISC = (volatile LAS unsigned*)(F.lds + MISC_OFF);
    for (int u = F.tid; u < (LDS_BYTES - MISC_OFF) / 4; u += NWAVES * 64) ((LAS unsigned*)(F.lds + MISC_OFF))[u] = 0u;
    __syncthreads();
    XcdBarrier bar; bar.bar = (unsigned*)(F.ws + WS_CTL) + CW_BAR; bar.x = 0; bar.st = nullptr;
    if (args.use_bar == 2) bar = xcd_barrier_post((unsigned*)(F.ws + WS_CTL) + CW_BAR, MISC + 8);
    const int lo = args.ph_lo, hi = args.ph_hi;
#define IN(k) (lo <= (k) && (k) < hi)
#define SEAM(k) do { if (IN(k) && IN((k) + 1)) { if (args.use_bar == 2) xcd_barrier(bar); else cg::this_grid().sync(); } } while (0)

    if (IN(0) && !(SKIPMASK & 1)) for (int rep_ = 0; rep_ < (((DUPMASK >> 0) & 1) ? 2 : 1); ++rep_) { p0_prologue(F); }
    SEAM(0);
    if (IN(1) && !(SKIPMASK & 2)) for (int rep_ = 0; rep_ < (((DUPMASK >> 1) & 1) ? 2 : 1); ++rep_) {
        pg8::Gemm g{(const pg8::bf16_t*)(F.ws + WS_A0), (const pg8::bf16_t*)(F.ws + WS_WIN), MP, DIN, DM}; pg8::StaticOrder S; S.init(MP, DIN, F.G, F.bid);
        EpiIn E{(bf16*)(F.ws + WS_QB), (bf16*)(F.ws + WS_KB), (bf16*)(F.ws + WS_VB), (bf16*)(F.ws + WS_UB), (bf16*)(F.ws + WS_GVB), (const float*)(F.ws + WS_ROPE), F.in[6], F.in[7], F.in[9], F.out};
        pg8::gemm_phase<EpiIn, pg8::StaticOrder, true, true>(F.lds, g, S, E);
    }
    SEAM(1);
    if (IN(2) && !(SKIPMASK & 4)) for (int rep_ = 0; rep_ < (((DUPMASK >> 2) & 1) ? 2 : 1); ++rep_) {
        constexpr int NU = 512 + 512 + NSMP;
        for (int u = F.bid; u < NU; u += F.G) {
            if (u < 512) gate_unit(F, (u & ~3) | (3 - (u & 3)));
            else if (u < 1024) attn_unit(F, u - 512);
            else sample_unit(F, u - 1024);
        }
    }
    SEAM(2);
    if (IN(3) && !(SKIPMASK & 8)) for (int rep_ = 0; rep_ < (((DUPMASK >> 3) & 1) ? 2 : 1); ++rep_) {
        pg8::Gemm g{(const pg8::bf16_t*)(F.ws + WS_A1), (const pg8::bf16_t*)(F.ws + WS_WO), MP, DM, DM}; pg8::StaticOrder S; S.init(MP, DM, F.G, F.bid);
        EpiOut E{F.in[0], F.in[1], F.out, (bf16*)(F.ws + WS_A0), (float*)(F.ws + WS_ROWSS)};
        pg8::gemm_phase<EpiOut, pg8::StaticOrder, true, true>(F.lds, g, S, E);
    }
    SEAM(3);
    if (IN(4) && !(SKIPMASK & 16)) for (int rep_ = 0; rep_ < (((DUPMASK >> 4) & 1) ? 2 : 1); ++rep_) {
        pg8::Gemm g{(const pg8::bf16_t*)(F.ws + WS_A0), (const pg8::bf16_t*)(F.ws + WS_WQ), MP, NQ, DM}; pg8::StaticOrder S; S.init(MP, NQ, F.G, F.bid);
        EpiQ E{(bf16*)(F.ws + WS_QP), (const float*)(F.ws + WS_ROWSS)};
        pg8::gemm_phase<EpiQ, pg8::StaticOrder, true, true>(F.lds, g, S, E);
    }
    SEAM(4);
    if (IN(5) && !(SKIPMASK & 32)) for (int rep_ = 0; rep_ < (((DUPMASK >> 5) & 1) ? 2 : 1); ++rep_) {
        const int gw = F.bid * NWAVES + F.wave, NGW = F.G * NWAVES;
        for (int t = gw; t < (MP / 32) * 4; t += NGW) route_task(F, t >> 2, t & 3);
    }
    SEAM(5);
    if (IN(6) && !(SKIPMASK & 64)) for (int rep_ = 0; rep_ < (((DUPMASK >> 6) & 1) ? 2 : 1); ++rep_) {
        const int x = F.bid & 7, nb = (F.G - x + 7) >> 3, gwx = (F.bid >> 3) * NWAVES + F.wave;
        upass(F, x, gwx, nb * NWAVES);
    }
    SEAM(6);
    if (IN(7) && !(SKIPMASK & 128)) for (int rep_ = 0; rep_ < (((DUPMASK >> 7) & 1) ? 2 : 1); ++rep_) {
        const int gt = F.bid * 512 + F.tid, NGT = F.G * 512;
        const float* part = (const float*)(F.ws + WS_PART); const float* rg = (const float*)(F.ws + WS_RG); float* rw = (float*)(F.ws + WS_RW);
        const unsigned short* rid = (const unsigned short*)(F.ws + WS_RID); const float* su = (const float*)(F.ws + WS_SU);
        for (int i = gt; i < MTOK * 128; i += NGT) {
            float d = 0.f;
#pragma unroll
            for (int xx = 0; xx < 8; ++xx) d += part[(size_t)xx * MTOK * 128 + i];
            const int e = rid[i];
            rw[i] = rg[i] * gelu1(d * su[e]) * su[NEXP + e];
        }
    }
    SEAM(7);
    if (IN(8)) {
        const int x = F.bid & 7, nb = (F.G - x + 7) >> 3, gwx = (F.bid >> 3) * NWAVES + F.wave;
        vpass(F, x, gwx, nb * NWAVES);
    }
#undef IN
#undef SEAM
}

#ifndef MK_N_LAUNCHES
#define MK_N_LAUNCHES 1
#endif
extern "C" void kernel_launch(void* const* d_in, const int* in_sizes, int n_in, void* d_out, int out_size, void* d_ws, size_t ws_size, hipStream_t stream) {
    static int grid = 0;
    if (grid == 0) {
        if (n_in != 19 || out_size != (int)O_END || ws_size < WS_END) { fprintf(stderr, "kernel_launch: unexpected shapes (n_in %d out %d ws %zu)\n", n_in, out_size, ws_size); grid = -1; return; }
        int dev = 0, cus = 0, per_cu = 0;
        hipGetDevice(&dev); hipDeviceGetAttribute(&cus, hipDeviceAttributeMultiprocessorCount, dev);
        if (hipFuncSetAttribute((const void*)mk_fwd, hipFuncAttributeMaxDynamicSharedMemorySize, LDS_BYTES) != hipSuccess) { fprintf(stderr, "kernel_launch: hipFuncSetAttribute failed\n"); grid = -1; return; }
        if (hipOccupancyMaxActiveBlocksPerMultiprocessor(&per_cu, (const void*)mk_fwd, NWAVES * 64, LDS_BYTES) != hipSuccess || per_cu < 1) { fprintf(stderr, "kernel_launch: occupancy query says %d\n", per_cu); }
        (void)hipGetLastError();
        grid = cus;
    }
    if (grid < 0) return;
    hipMemsetAsync((char*)d_ws + WS_CTL, 0, CTL_ZERO_BYTES, stream);
    Args a{};
    for (int i = 0; i < 19; ++i) a.in[i] = (const float*)d_in[i];
    a.out = (float*)d_out; a.ws = (unsigned char*)d_ws;
#if MK_N_LAUNCHES == 1
    a.ph_lo = 0; a.ph_hi = NPHASE; a.use_bar = MK_BAR_KIND;
    void* kargs[] = {&a};
    hipError_t e = hipLaunchCooperativeKernel((const void*)mk_fwd, dim3(grid), dim3(NWAVES * 64), kargs, LDS_BYTES, stream);
    if (e != hipSuccess) fprintf(stderr, "cooperative launch failed: %s (grid %d)\n", hipGetErrorString(e), grid);
#else
    for (int li = 0; li < NPHASE; ++li) {
        a.ph_lo = li; a.ph_hi = li + 1; a.use_bar = 0;
        hipLaunchKernelGGL(mk_fwd, dim3(grid), dim3(NWAVES * 64), LDS_BYTES, stream, a);
    }
#endif
}
```
